# Optimizing an MI355X kernel written in HIP

```python
import math
import numpy as np
import jax
import jax.numpy as jnp
from jax import lax

D_MODEL = 1024
BATCH = 8
SEQ = 4096
DEPTH = 4

EPS = 1e-6
ROPE_THETA = 10000.0
MASK_VALUE = -1e30

DN_HEADS = 4
DN_DK = 128
DN_DV = 128
DN_CONV = 4
DN_CHUNK = 64
SC_CHANNELS = 512
SC_CONV = 3
HG_HEADS = 4
HG_DK = 128
HG_DV = 128
HG_CHUNK = 64
SWA_PATTERNS = ((128, 1), (512, 4), (2048, 16))
SWA_HEADS = 4
SWA_DH = 128
FFN_HIDDEN = -(-8 * D_MODEL // (3 * 256)) * 256

DN_W = DN_HEADS * DN_DK
DN_VW = DN_HEADS * DN_DV
AB_SPLITS = (2 * DN_W + DN_VW, DN_VW, DN_HEADS, DN_HEADS, SC_CHANNELS, SC_CHANNELS, SC_CHANNELS)
AB_IN = sum(AB_SPLITS)
AB_OUT = DN_VW + SC_CHANNELS
HG_W = HG_HEADS * HG_DK
HG_VW = HG_HEADS * HG_DV
SWA_W = len(SWA_PATTERNS) * SWA_HEADS * SWA_DH
CD_SPLITS = (HG_W, HG_W, HG_VW, HG_VW, SWA_W, SWA_W, SWA_W)
CD_IN = sum(CD_SPLITS)
CD_OUT = HG_VW + SWA_HEADS * SWA_DH
N_EVEN = (DEPTH + 1) // 2
N_ODD = DEPTH // 2

kernel_name = 'hybrid_deltanet_shortconv_hgrn2_dilated_swa'


def rms_norm(x, g):
    xf = x.astype(jnp.float32)
    y = xf * lax.rsqrt(jnp.mean(xf * xf, axis=-1, keepdims=True) + EPS)
    return (y * g.astype(jnp.float32)).astype(x.dtype)


def l2_normalize(x):
    xf = x.astype(jnp.float32)
    return xf * lax.rsqrt(jnp.sum(xf * xf, axis=-1, keepdims=True) + EPS)


def split_cols(a, sizes):
    return jnp.split(a, [int(s) for s in np.cumsum(sizes)[:-1]], axis=-1)


def causal_depthwise_conv(x, w):
    width = w.shape[0]
    t = x.shape[1]
    xp = jnp.pad(x, ((0, 0), (width - 1, 0), (0, 0)))
    return sum(xp[:, j:j + t] * w[j] for j in range(width))


def masked_exp(mask, logits):
    return jnp.where(mask, jnp.exp(jnp.where(mask, logits, 0.0)), 0.0)


def rope(x, pos):
    dh = x.shape[-1]
    half = dh // 2
    inv_freq = ROPE_THETA ** (-jnp.arange(half, dtype=jnp.float32) * 2.0 / dh)
    ang = pos.astype(jnp.float32)[:, None] * inv_freq[None, :]
    shape = (1, x.shape[1]) + (1,) * (x.ndim - 3) + (half,)
    cos = jnp.cos(ang).reshape(shape)
    sin = jnp.sin(ang).reshape(shape)
    xf = x.astype(jnp.float32)
    x1, x2 = xf[..., :half], xf[..., half:]
    return jnp.concatenate([x1 * cos - x2 * sin, x1 * sin + x2 * cos], axis=-1).astype(x.dtype)


def to_chunks(a, c):
    b, t = a.shape[:2]
    a = a.reshape((b, t // c, c) + a.shape[2:])
    return jnp.moveaxis(jnp.moveaxis(a, 1, 0), 2, 3)


def from_chunks(a):
    a = jnp.moveaxis(jnp.moveaxis(a, 3, 2), 0, 1)
    n_b, n, c, h, d = a.shape
    return a.reshape(n_b, n * c, h, d)


def gated_delta_rule(q, k, v, g, beta):
    f32 = jnp.float32
    b, t, h, dk = q.shape
    dv = v.shape[-1]
    c = DN_CHUNK
    q, k, v = (to_chunks(a.astype(f32), c) for a in (q, k, v))
    gc = jnp.cumsum(to_chunks(g.astype(f32), c), axis=-1)
    bt = to_chunks(beta.astype(f32), c)
    causal = jnp.tril(jnp.ones((c, c), bool))
    decay = masked_exp(causal, gc[..., :, None] - gc[..., None, :])
    kk = jnp.einsum('nbhcd,nbhsd->nbhcs', k, k)
    a_strict = jnp.where(jnp.eye(c, dtype=bool), 0.0, bt[..., None] * kk * decay)
    rhs = jnp.concatenate([v * bt[..., None], k * (bt * jnp.exp(gc))[..., None]], axis=-1)
    sol = lax.linalg.triangular_solve(a_strict + jnp.eye(c, dtype=f32), rhs,
                                      left_side=True, lower=True, unit_diagonal=True)
    u_base, w = sol[..., :dv], sol[..., dv:]
    qk = jnp.einsum('nbhcd,nbhsd->nbhcs', q, k) * decay
    q_dec = q * jnp.exp(gc)[..., None]
    k_dec = k * jnp.exp(gc[..., -1:] - gc)[..., None]
    g_tot = jnp.exp(gc[..., -1])

    def step(state, inp):
        u_b, w_c, qk_c, qd_c, kd_c, gt_c = inp
        u = u_b - jnp.einsum('bhcd,bhde->bhce', w_c, state)
        o = jnp.einsum('bhcd,bhde->bhce', qd_c, state) + jnp.einsum('bhcs,bhse->bhce', qk_c, u)
        state = state * gt_c[..., None, None] + jnp.einsum('bhcd,bhce->bhde', kd_c, u)
        return state, o

    s0 = jnp.zeros((b, h, dk, dv), f32)
    _, o = lax.scan(step, s0, (u_base, w, qk, q_dec, k_dec, g_tot))
    return from_chunks(o)


def hgrn2_recurrence(q, k, v, log_f):
    f32 = jnp.float32
    b, t, h, dk = q.shape
    dv = v.shape[-1]
    c = HG_CHUNK
    q, k, v, lf = (to_chunks(a.astype(f32), c) for a in (q, k, v, log_f))
    bcum = jnp.cumsum(lf, axis=3)
    causal = jnp.tril(jnp.ones((c, c), bool))[:, :, None]

    def step(state, inp):
        q_c, k_c, v_c, b_c = inp
        decay = masked_exp(causal, b_c[:, :, :, None, :] - b_c[:, :, None, :, :])
        attn = jnp.einsum('bhtsd,bhsd->bhts', decay * q_c[:, :, :, None, :], k_c)
        o = (jnp.einsum('bhts,bhse->bhte', attn, v_c)
             + jnp.einsum('bhtd,bhde->bhte', q_c * jnp.exp(b_c), state))
        b_last = b_c[:, :, -1:, :]
        state = (state * jnp.exp(b_last[:, :, 0, :, None])
                 + jnp.einsum('bhsd,bhse->bhde', k_c * jnp.exp(b_last - b_c), v_c))
        return state, o

    s0 = jnp.zeros((b, h, dk, dv), f32)
    _, o = lax.scan(step, s0, (q, k, v, bcum))
    return from_chunks(o)


def dilated_window_attention(q, k, v, window, dilation):
    f32 = jnp.float32
    b, t, h, dh = q.shape
    span = window // dilation
    length = t // dilation
    nb = -(-length // span)
    pad = nb * span - length

    def blocks(a):
        a = a.astype(f32).reshape(b, length, dilation, h, dh).transpose(0, 2, 3, 1, 4)
        a = jnp.pad(a, ((0, 0), (0, 0), (0, 0), (0, pad), (0, 0)))
        return a.reshape(b, dilation, h, nb, span, dh)

    def with_prev(a):
        prev = jnp.pad(a, ((0, 0), (0, 0), (0, 0), (1, 0), (0, 0), (0, 0)))[:, :, :, :-1]
        return jnp.concatenate([prev, a], axis=4)

    qb = blocks(q)
    kb = with_prev(blocks(k))
    vb = with_prev(blocks(v))
    s = jnp.einsum('brhnqd,brhnkd->brhnqk', qb, kb) * (dh ** -0.5)
    qi = jnp.arange(span)[:, None]
    kj = jnp.arange(2 * span)[None, :]
    dist = qi + span - kj
    in_range = jnp.arange(nb)[:, None, None] * span + kj - span >= 0
    valid = (dist >= 0) & (dist <= span) & in_range
    s = jnp.where(valid, s, MASK_VALUE)
    m = jnp.max(s, axis=-1, keepdims=True)
    p = jnp.where(valid, jnp.exp(s - m), 0.0)
    l = jnp.sum(p, axis=-1, keepdims=True)
    o = jnp.einsum('brhnqk,brhnkd->brhnqd', p / l, vb)
    lse = (m + jnp.log(l))[..., 0]
    o = o.reshape(b, dilation, h, nb * span, dh)[:, :, :, :length].transpose(0, 3, 1, 2, 4).reshape(b, t, h, dh)
    lse = lse.reshape(b, dilation, h, nb * span)[..., :length].transpose(0, 3, 1, 2).reshape(b, t, h)
    return o, lse


def mixer_ab(h, w_in, conv_w, a_log, dt_bias, norm_g, sc_conv_w, w_out):
    f32 = jnp.float32
    b, t, _ = h.shape
    qkv, z, beta_raw, alpha_raw, gate_b, gate_c, sc_in = split_cols(h @ w_in, AB_SPLITS)
    qkv = jax.nn.silu(causal_depthwise_conv(qkv, conv_w))
    q, k, v = split_cols(qkv, (DN_W, DN_W, DN_VW))
    q = l2_normalize(q.reshape(b, t, DN_HEADS, DN_DK)) * (DN_DK ** -0.5)
    k = l2_normalize(k.reshape(b, t, DN_HEADS, DN_DK))
    v = v.reshape(b, t, DN_HEADS, DN_DV)
    beta = jax.nn.sigmoid(beta_raw.astype(f32))
    g = -jnp.exp(a_log.astype(f32)) * jax.nn.softplus(alpha_raw.astype(f32) + dt_bias.astype(f32))
    o_a = gated_delta_rule(q, k, v, g, beta)
    o_a = (rms_norm(o_a, norm_g) * jax.nn.silu(z.reshape(b, t, DN_HEADS, DN_DV))).reshape(b, t, DN_VW)
    o_b = gate_b * causal_depthwise_conv(gate_c * sc_in, sc_conv_w)
    return jnp.concatenate([o_a.astype(h.dtype), o_b.astype(h.dtype)], axis=-1) @ w_out


def mixer_cd(h, w_in, lower_bound, norm_g, w_out):
    f32 = jnp.float32
    b, t, _ = h.shape
    hq, hf, hi, hg, sq, sk, sv = split_cols(h @ w_in, CD_SPLITS)
    lb = lower_bound.astype(f32)
    hf = hf.astype(f32)
    f_gate = lb + (1.0 - lb) * jax.nn.sigmoid(hf)
    log_f = jnp.log(f_gate)
    k_in = (1.0 - lb) * jax.nn.sigmoid(-hf)
    hgrn_heads = lambda a, d: a.reshape(b, t, HG_HEADS, d)
    o_c = hgrn2_recurrence(hgrn_heads(jax.nn.silu(hq), HG_DK), hgrn_heads(k_in, HG_DK),
                           hgrn_heads(hi, HG_DV), hgrn_heads(log_f, HG_DK))
    o_c = (rms_norm(o_c, norm_g) * jax.nn.sigmoid(hgrn_heads(hg, HG_DV).astype(f32))).reshape(b, t, HG_VW)
    n_pat = len(SWA_PATTERNS)
    pos = jnp.arange(t)
    sq = rope(sq.reshape(b, t, n_pat, SWA_HEADS, SWA_DH), pos)
    sk = rope(sk.reshape(b, t, n_pat, SWA_HEADS, SWA_DH), pos)
    sv = sv.reshape(b, t, n_pat, SWA_HEADS, SWA_DH)
    outs, lses = [], []
    for p, (window, dilation) in enumerate(SWA_PATTERNS):
        o_p, lse_p = dilated_window_attention(sq[:, :, p], sk[:, :, p], sv[:, :, p], window, dilation)
        outs.append(o_p)
        lses.append(lse_p)
    wts = jax.nn.softmax(jnp.stack(lses, axis=-1), axis=-1)
    o_d = jnp.einsum('bthpd,bthp->bthd', jnp.stack(outs, axis=3), wts).reshape(b, t, SWA_HEADS * SWA_DH)
    return jnp.concatenate([o_c.astype(h.dtype), o_d.astype(h.dtype)], axis=-1) @ w_out


def swiglu(h, w_gate, w_up, w_down):
    return (jax.nn.silu(h @ w_gate) * (h @ w_up)) @ w_down


def setup_inputs(seed: int = 0) -> dict:
    key = jax.random.key(seed)
    keys = iter(jax.random.split(key, 24))
    f32 = jnp.float32

    def dense(shape, fan_in):
        return jax.random.normal(next(keys), shape, f32) * (fan_in ** -0.5)

    def gain(shape):
        return 1.0 + 0.02 * jax.random.normal(next(keys), shape, f32)

    x = jax.random.normal(next(keys), (BATCH, SEQ, D_MODEL), f32)
    norm_mix_g = gain((DEPTH, D_MODEL))
    norm_ffn_g = gain((DEPTH, D_MODEL))
    norm_final_g = gain((D_MODEL,))
    ab_w_in = dense((N_EVEN, D_MODEL, AB_IN), D_MODEL)
    dn_conv_w = dense((N_EVEN, DN_CONV, 2 * DN_W + DN_VW), DN_CONV)
    dn_a_log = jnp.log(jax.random.uniform(next(keys), (N_EVEN, DN_HEADS), f32, 1.0, 16.0))
    dt = jnp.exp(jax.random.uniform(next(keys), (N_EVEN, DN_HEADS), f32, math.log(1e-3), math.log(1e-1)))
    dn_dt_bias = dt + jnp.log(-jnp.expm1(-dt))
    dn_norm_g = gain((N_EVEN, DN_DV))
    sc_conv_w = dense((N_EVEN, SC_CONV, SC_CHANNELS), SC_CONV)
    ab_w_out = dense((N_EVEN, AB_OUT, D_MODEL), AB_OUT)
    cd_w_in = dense((N_ODD, D_MODEL, CD_IN), D_MODEL)
    hg_lower_bounds = 0.1 * jax.random.normal(next(keys), (N_ODD, HG_W), f32)
    hg_norm_g = gain((N_ODD, HG_DV))
    cd_w_out = dense((N_ODD, CD_OUT, D_MODEL), CD_OUT)
    ffn_w_gate = dense((DEPTH, D_MODEL, FFN_HIDDEN), D_MODEL)
    ffn_w_up = dense((DEPTH, D_MODEL, FFN_HIDDEN), D_MODEL)
    ffn_w_down = dense((DEPTH, FFN_HIDDEN, D_MODEL), FFN_HIDDEN)
    return {'x': x, 'norm_mix_g': norm_mix_g, 'norm_ffn_g': norm_ffn_g, 'norm_final_g': norm_final_g,
            'ab_w_in': ab_w_in, 'dn_conv_w': dn_conv_w, 'dn_a_log': dn_a_log, 'dn_dt_bias': dn_dt_bias,
            'dn_norm_g': dn_norm_g, 'sc_conv_w': sc_conv_w, 'ab_w_out': ab_w_out,
            'cd_w_in': cd_w_in, 'hg_lower_bounds': hg_lower_bounds, 'hg_norm_g': hg_norm_g,
            'cd_w_out': cd_w_out, 'ffn_w_gate': ffn_w_gate, 'ffn_w_up': ffn_w_up, 'ffn_w_down': ffn_w_down}


def reference(x, norm_mix_g, norm_ffn_g, norm_final_g, ab_w_in, dn_conv_w, dn_a_log, dn_dt_bias,
              dn_norm_g, sc_conv_w, ab_w_out, cd_w_in, hg_lower_bounds, hg_norm_g, cd_w_out,
              ffn_w_gate, ffn_w_up, ffn_w_down):
    sm = jax.nn.softmax(hg_lower_bounds.astype(jnp.float32), axis=0)
    lower_bounds = jnp.cumsum(sm, axis=0) - sm[0]
    h = x
    for layer in range(DEPTH):
        i = layer // 2
        hn = rms_norm(h, norm_mix_g[layer])
        if layer % 2 == 0:
            h = h + mixer_ab(hn, ab_w_in[i], dn_conv_w[i], dn_a_log[i], dn_dt_bias[i], dn_norm_g[i],
                             sc_conv_w[i], ab_w_out[i])
        else:
            h = h + mixer_cd(hn, cd_w_in[i], lower_bounds[i], hg_norm_g[i], cd_w_out[i])
        hn = rms_norm(h, norm_ffn_g[layer])
        h = h + swiglu(hn, ffn_w_gate[layer], ffn_w_up[layer], ffn_w_down[layer])
    return rms_norm(h, norm_final_g)
```

```cpp
#include <hip/hip_runtime.h>
#include <hip/hip_bf16.h>
#include <hip/hip_cooperative_groups.h>
#include <cstdio>
namespace cg = cooperative_groups;

typedef unsigned short bfu;
using bf16x8 = __attribute__((ext_vector_type(8))) short;
using f32x4 = __attribute__((ext_vector_type(4))) float;
using u32x4 = __attribute__((ext_vector_type(4))) unsigned;
using u32x2 = __attribute__((ext_vector_type(2))) unsigned;
#define LBAR do { asm volatile("s_waitcnt lgkmcnt(0)" ::: "memory"); __builtin_amdgcn_s_barrier(); asm volatile("" ::: "memory"); } while (0)
#define GPTR(T, ptr) ((__attribute__((address_space(1))) T*)(ptr))

#define MTOK 32768
#define TSEQ 4096
#define NTHR 512

#define WT_OFF 0L
#define MISC_OFF (114L << 20)
#define HB_OFF (130L << 20)
#define R_OFF (194L << 20)
#define PAB_OFF (R_OFF + (80L << 20))
#define DNP_OFF HB_OFF
#define MF_ROWSS 0
#define MF_LB 294912
#define MF_WBA 295936
#define MF_BG 312320
#define MF_GTOT 574464
#define MF_EB 576512
#define MF_LSE 838656
#define MF_ROPE 1231872
#define MF_RSP 1760000
#define BAR_BYTE_OFF (MISC_OFF + (15L << 20))

struct Params {
  const float* x; const float* norm_mix_g; const float* norm_ffn_g; const float* norm_final_g;
  const float* ab_w_in; const float* dn_conv_w; const float* dn_a_log; const float* dn_dt_bias;
  const float* dn_norm_g; const float* sc_conv_w; const float* ab_w_out; const float* cd_w_in;
  const float* hg_lb; const float* hg_norm_g; const float* cd_w_out;
  const float* ffn_w_gate; const float* ffn_w_up; const float* ffn_w_down;
  float* out; char* ws;
  int phase_lo, phase_hi;
  int tid, bid;
};

extern __shared__ __attribute__((aligned(16))) unsigned char smem[];

__device__ __forceinline__ bfu f2bf(float f) {
  unsigned u = __float_as_uint(f);
  u += 0x7fffu + ((u >> 16) & 1u);
  return (bfu)(u >> 16);
}
__device__ __forceinline__ float bf2f(bfu h) { return __uint_as_float(((unsigned)h) << 16); }
__device__ __forceinline__ unsigned pack2(float a, float b) { return (unsigned)f2bf(a) | ((unsigned)f2bf(b) << 16); }
__device__ __forceinline__ float fexp(float x) { return __builtin_amdgcn_exp2f(x * 1.4426950408889634f); }
__device__ __forceinline__ float flog(float x) { return __builtin_amdgcn_logf(x) * 0.6931471805599453f; }
__device__ __forceinline__ float frsq(float x) { return __builtin_amdgcn_rsqf(x); }
__device__ __forceinline__ float frcp(float x) { return __builtin_amdgcn_rcpf(x); }
__device__ __forceinline__ float sigmoidf_(float x) { return frcp(1.0f + fexp(-x)); }
__device__ __forceinline__ float siluf_(float x) { return x * frcp(1.0f + fexp(-x)); }

__device__ __forceinline__ float shx_(float v, int m, int lane) { return __builtin_bit_cast(float, __builtin_amdgcn_ds_bpermute((lane ^ m) << 2, __builtin_bit_cast(int, v))); }
__device__ __forceinline__ float shup_(float v, int o, int lane) { return __builtin_bit_cast(float, __builtin_amdgcn_ds_bpermute((lane - o) << 2, __builtin_bit_cast(int, v))); }
#define SHX(v, m) shx_((v), (m), lane)
__device__ __forceinline__ long wt_base(int L) { return ((long)(L >> 1) * 29184L + (long)(L & 1) * 13056L) * 1024L; }

__device__ __forceinline__ int ptid_(int wave) { int l_; asm volatile("v_mbcnt_lo_u32_b32 %0, -1, 0\n\tv_mbcnt_hi_u32_b32 %0, -1, %0" : "=v"(l_)); return (wave << 6) | l_; }
constexpr int BM = 256, BK = 64, HALF = 128, HT = HALF * BK;

__device__ __forceinline__ int lds_byte(int r, int c) {
  int st = (r >> 4) * 2 + (c >> 5), rr = r & 15, cc = c & 31, ob = rr * 64 + cc * 2;
  return st * 1024 + (ob ^ (((ob >> 9) & 1) << 5));
}
__device__ __forceinline__ void stage_rc(int b, int& R, int& C) {
  int st = b / 1024, sb = b % 1024, swz = sb ^ (((sb >> 9) & 1) << 5);
  R = (st >> 1) * 16 + swz / 64; C = (st & 1) * 32 + (swz % 64) / 2;
}

struct GemmArgs {
  const bfu* A; int lda; int aoff0, aoff1, asplit;
  const bfu* Bt; int K;
  const float* rowss;
  bfu* outb; int ldo; int ocol0;
  const float* hres; float* hout; bfu* hb; float* rowss_next;
  const float* rope;
  int tid;
  int res_bf16;
};

enum { EPI_PLAIN = 0, EPI_SWA = 1, EPI_RES = 2, EPI_GLU = 3 };

template <int EPI>
__device__ __forceinline__ void gemm_tile(const GemmArgs& g, int brow, int bcol, int parity, bool first, bool nvalid, int nbrow, int nbcol) {
  bfu* shm = (bfu*)smem;
  const bfu* A = g.A; const bfu* Bt = g.Bt; const int K = g.K; const int lda = g.lda;
#define SA(b, h) (shm + ((b) * 2 + (h)) * HT)
#define SB(b, h) (shm + (4 + (b) * 2 + (h)) * HT)
#define STAGE_A(P, br, kt) do { int _kc = (kt) * BK; int _ac = (_kc < g.asplit) ? (g.aoff0 + _kc) : (g.aoff1 + _kc - g.asplit); \
    const char* _gb = (const char*)(A + ((long)(br) * lda + _ac)); \
    __builtin_amdgcn_global_load_lds((const unsigned*)(_gb + aofl0), (unsigned*)((char*)(P) + gtid_ * 16), 16, 0, 0); \
    __builtin_amdgcn_global_load_lds((const unsigned*)(_gb + (long)lda * 128 + aofl0), (unsigned*)((char*)(P) + gtid_ * 16 + 8192), 16, 0, 0); } while (0)
#define STAGE_B(P, br, kt) do { const char* _gb = (const char*)(Bt + ((long)(br) * K + (long)(kt) * BK)); \
    __builtin_amdgcn_global_load_lds((const unsigned*)(_gb + bofl0), (unsigned*)((char*)(P) + gtid_ * 16), 16, 0, 0); \
    __builtin_amdgcn_global_load_lds((const unsigned*)(_gb + (long)K * 128 + bofl0), (unsigned*)((char*)(P) + gtid_ * 16 + 8192), 16, 0, 0); } while (0)
#define LDA(dst, b, h) for (int m = 0; m < 4; ++m) for (int k = 0; k < 2; ++k) \
    dst[m][k] = *reinterpret_cast<const bf16x8*>((char*)SA(b, h) + lds_byte(wr * 64 + m * 16 + fr, k * 32 + fq * 8))
#define LDB(dst, b, h) for (int n = 0; n < 2; ++n) for (int k = 0; k < 2; ++k) \
    dst[n][k] = *reinterpret_cast<const bf16x8*>((char*)SB(b, h) + lds_byte(wc * 32 + n * 16 + fr, k * 32 + fq * 8))
#define MMA(ai, bj, At_, Bt_) do { __builtin_amdgcn_s_setprio(1); \
    for (int m = 0; m < 4; ++m) for (int n = 0; n < 2; ++n) for (int k = 0; k < 2; ++k) \
      acc[ai][bj][m][n] = __builtin_amdgcn_mfma_f32_16x16x32_bf16(At_[m][k], Bt_[n][k], acc[ai][bj][m][n], 0, 0, 0); \
    __builtin_amdgcn_s_setprio(0); } while (0)
#define WAIT_V(n) asm volatile("s_waitcnt vmcnt(" #n ")" ::: "memory")
#define WAIT_L(n) asm volatile("s_waitcnt lgkmcnt(" #n ")" ::: "memory")
#define BAR __builtin_amdgcn_s_barrier()
#define SCHED __builtin_amdgcn_sched_barrier(0)

  int gtid_ = ptid_(g.tid);
  const int wid = gtid_ >> 6, lane = gtid_ & 63, wr = wid >> 2, wc = wid & 3, fr = lane & 15, fq = lane >> 4;
  unsigned aofl0, bofl0;
  { int _r, _c; stage_rc(gtid_ * 16, _r, _c); aofl0 = (unsigned)(_r * lda + _c) * 2u; bofl0 = (unsigned)(_r * K + _c) * 2u; }
  f32x4 acc[2][2][4][2] = {};
  bf16x8 At[4][2], B0[2][2], B1[2][2];
  const int nt = K / BK;
  float* rstd_s = (float*)(smem + 153600) + (parity & 1) * 256;
  if (first) {
    WAIT_V(0);
    __syncthreads();
    STAGE_B(SB(0, 0), bcol, 0); STAGE_A(SA(0, 0), brow, 0);
    STAGE_B(SB(0, 1), bcol + HALF, 0); STAGE_A(SA(0, 1), brow + HALF, 0);
  }
  f32x4 ra0, ra1, ra2, ra3;
  if constexpr (EPI != EPI_RES) {
    if (gtid_ < 256) {
      const __attribute__((address_space(1))) f32x4* pp = GPTR(const f32x4, g.rowss + (long)(brow + gtid_) * 16);
      ra0 = pp[0]; ra1 = pp[1]; ra2 = pp[2]; ra3 = pp[3];
    }
  }
  if (wr == 1) BAR;
  if (first) { WAIT_V(4); } else { WAIT_V(0); }
  BAR;
  if constexpr (EPI != EPI_RES) {
    if (gtid_ < 256) {
      float s = ((ra0[0] + ra0[1]) + (ra0[2] + ra0[3])) + ((ra1[0] + ra1[1]) + (ra1[2] + ra1[3])) + ((ra2[0] + ra2[1]) + (ra2[2] + ra2[3])) + ((ra3[0] + ra3[1]) + (ra3[2] + ra3[3]));
      rstd_s[gtid_] = frsq(s * (1.0f / 1024.0f) + 1e-6f);
    }
  }
  STAGE_B(SB(1, 0), bcol, 1); STAGE_A(SA(1, 0), brow, 1); STAGE_B(SB(1, 1), bcol + HALF, 1);
  WAIT_V(6); BAR;
  for (int t = 0; t < nt - 2; t += 2) {
    LDB(B0, 0, 0); SCHED; LDA(At, 0, 0); STAGE_A(SA(1, 1), brow + HALF, t + 1);
    WAIT_L(8); BAR; WAIT_L(0); MMA(0, 0, At, B0); BAR; SCHED;
    LDB(B1, 0, 1); STAGE_B(SB(0, 0), bcol, t + 2);
    BAR; WAIT_L(0); MMA(0, 1, At, B1); BAR; SCHED;
    LDA(At, 0, 1); STAGE_A(SA(0, 0), brow, t + 2);
    BAR; WAIT_L(0); MMA(1, 0, At, B0); BAR; SCHED;
    STAGE_B(SB(0, 1), bcol + HALF, t + 2);
    WAIT_V(6); BAR; MMA(1, 1, At, B1); BAR; SCHED;
    LDB(B0, 1, 0); SCHED; LDA(At, 1, 0); STAGE_A(SA(0, 1), brow + HALF, t + 2);
    WAIT_L(8); BAR; WAIT_L(0); MMA(0, 0, At, B0); BAR; SCHED;
    LDB(B1, 1, 1); STAGE_B(SB(1, 0), bcol, t + 3);
    BAR; WAIT_L(0); MMA(0, 1, At, B1); BAR; SCHED;
    LDA(At, 1, 1); STAGE_A(SA(1, 0), brow, t + 3);
    BAR; WAIT_L(0); MMA(1, 0, At, B0); BAR; SCHED;
    STAGE_B(SB(1, 1), bcol + HALF, t + 3);
    WAIT_V(6); BAR; MMA(1, 1, At, B1); BAR; SCHED;
  }
  { LDB(B0, 0, 0); LDA(At, 0, 0); STAGE_A(SA(1, 1), brow + HALF, nt - 1);
    BAR; WAIT_L(0); MMA(0, 0, At, B0); BAR;
    LDB(B1, 0, 1); BAR; WAIT_L(0); MMA(0, 1, At, B1); BAR; SCHED;
    LDA(At, 0, 1); WAIT_V(4); BAR; WAIT_L(0); MMA(1, 0, At, B0); MMA(1, 1, At, B1); BAR; }
  { LDB(B0, 1, 0); LDA(At, 1, 0); WAIT_V(2); BAR; WAIT_L(0); MMA(0, 0, At, B0); BAR;
    LDB(B1, 1, 1); WAIT_V(0); BAR; WAIT_L(0); MMA(0, 1, At, B1); BAR; SCHED;
    LDA(At, 1, 1); BAR; WAIT_L(0); MMA(1, 0, At, B0); MMA(1, 1, At, B1); BAR; }
  if (wr == 0) BAR;
  if (nvalid) {
    STAGE_B(SB(0, 0), nbcol, 0); STAGE_A(SA(0, 0), nbrow, 0);
    STAGE_B(SB(0, 1), nbcol + HALF, 0); STAGE_A(SA(0, 1), nbrow + HALF, 0);
  }

  int rowb_ = brow + wr * 64 + fq * 4; asm volatile("" : "+v"(rowb_));
  int colb_ = bcol + wc * 32 + fr; asm volatile("" : "+v"(colb_));
  float* W = (float*)(smem + ((wid < 3) ? (32768 + wid * 9216) : (98304 + (wid - 3) * 9216)));
  const int wrow0 = rowb_ - fq * 4;
  const int wcol0 = colb_ - fr;
  const int lrow0 = wrow0 - brow;
#define W_WRITE(m, n, j, v) W[((m) * 16 + fq * 4 + (j)) * 36 + (n) * 16 + fr] = (v)
#define W_STORE_BF16(dstbase, ld) do { _Pragma("unroll") for (int ps = 0; ps < 4; ++ps) { \
      const int r_ = ps * 16 + (lane >> 2), c_ = (lane & 3) * 8; \
      float4 v0 = *(const float4*)(W + r_ * 36 + c_), v1 = *(const float4*)(W + r_ * 36 + c_ + 4); \
      u32x4 o_; o_[0] = pack2(v0.x, v0.y); o_[1] = pack2(v0.z, v0.w); o_[2] = pack2(v1.x, v1.y); o_[3] = pack2(v1.z, v1.w); \
      *GPTR(u32x4, (dstbase) + (long)r_ * (ld) + c_) = o_; } } while (0)
  if constexpr (EPI == EPI_PLAIN) {
    _Pragma("unroll") for (int ai = 0; ai < 2; ++ai) _Pragma("unroll") for (int bj = 0; bj < 2; ++bj) {
      SCHED;
      _Pragma("unroll") for (int m = 0; m < 4; ++m) _Pragma("unroll") for (int j = 0; j < 4; ++j) {
        const float rs = rstd_s[lrow0 + ai * HALF + m * 16 + fq * 4 + j];
        _Pragma("unroll") for (int n = 0; n < 2; ++n) W_WRITE(m, n, j, acc[ai][bj][m][n][j] * rs);
      }
      bfu* dst = g.outb + (long)(wrow0 + ai * HALF) * g.ldo + g.ocol0 + wcol0 + bj * HALF;
      W_STORE_BF16(dst, g.ldo);
    }
  } else if constexpr (EPI == EPI_SWA) {
    const bool isrope = bcol < 3072;
    const float qs = (bcol < 1536) ? 0.08838834764831845f : 1.0f;
    if (isrope) {
      const int pc0 = wcol0 - bcol;
      const int hsel = pc0 >> 6, dd0 = pc0 & 63;
      float* Wa = W; float* Wb = W + 32 * 36;
      _Pragma("unroll") for (int ai = 0; ai < 2; ++ai) _Pragma("unroll") for (int mh = 0; mh < 2; ++mh) {
        SCHED;
        _Pragma("unroll") for (int mm = 0; mm < 2; ++mm) _Pragma("unroll") for (int j = 0; j < 4; ++j) {
          const int m = mh * 2 + mm;
          const float rs = rstd_s[lrow0 + ai * HALF + m * 16 + fq * 4 + j] * qs;
          _Pragma("unroll") for (int n = 0; n < 2; ++n) {
            Wa[(mm * 16 + fq * 4 + j) * 36 + n * 16 + fr] = acc[ai][0][m][n][j] * rs;
            Wb[(mm * 16 + fq * 4 + j) * 36 + n * 16 + fr] = acc[ai][1][m][n][j] * rs;
          }
        }
        f32x4 cv[2][2], sv[2][2];
        _Pragma("unroll") for (int ps = 0; ps < 2; ++ps) {
          const int t = (wrow0 + ai * HALF + mh * 32 + ps * 16 + (lane >> 2)) & (TSEQ - 1);
          const int dcol = dd0 + (lane & 3) * 8;
          cv[ps][0] = *GPTR(const f32x4, g.rope + t * 64 + dcol); cv[ps][1] = *GPTR(const f32x4, g.rope + t * 64 + dcol + 4);
          sv[ps][0] = *GPTR(const f32x4, g.rope + TSEQ * 64 + t * 64 + dcol); sv[ps][1] = *GPTR(const f32x4, g.rope + TSEQ * 64 + t * 64 + dcol + 4);
        }
        _Pragma("unroll") for (int ps = 0; ps < 2; ++ps) {
          const int r_ = ps * 16 + (lane >> 2), c_ = (lane & 3) * 8;
          const int grow = wrow0 + ai * HALF + mh * 32 + r_;
          const float4 xa0 = *(const float4*)(Wa + r_ * 36 + c_), xa1 = *(const float4*)(Wa + r_ * 36 + c_ + 4);
          const float4 xb0 = *(const float4*)(Wb + r_ * 36 + c_), xb1 = *(const float4*)(Wb + r_ * 36 + c_ + 4);
          const f32x4 c0v = cv[ps][0], c1v = cv[ps][1], s0v = sv[ps][0], s1v = sv[ps][1];
          u32x4 y1, y2;
          y1[0] = pack2(xa0.x * c0v[0] - xb0.x * s0v[0], xa0.y * c0v[1] - xb0.y * s0v[1]);
          y1[1] = pack2(xa0.z * c0v[2] - xb0.z * s0v[2], xa0.w * c0v[3] - xb0.w * s0v[3]);
          y1[2] = pack2(xa1.x * c1v[0] - xb1.x * s1v[0], xa1.y * c1v[1] - xb1.y * s1v[1]);
          y1[3] = pack2(xa1.z * c1v[2] - xb1.z * s1v[2], xa1.w * c1v[3] - xb1.w * s1v[3]);
          y2[0] = pack2(xa0.x * s0v[0] + xb0.x * c0v[0], xa0.y * s0v[1] + xb0.y * c0v[1]);
          y2[1] = pack2(xa0.z * s0v[2] + xb0.z * c0v[2], xa0.w * s0v[3] + xb0.w * c0v[3]);
          y2[2] = pack2(xa1.x * s1v[0] + xb1.x * c1v[0], xa1.y * s1v[1] + xb1.y * c1v[1]);
          y2[3] = pack2(xa1.z * s1v[2] + xb1.z * c1v[2], xa1.w * s1v[3] + xb1.w * c1v[3]);
          bfu* dst = g.outb + (long)grow * g.ldo + bcol + hsel * 128 + dd0 + c_;
          *GPTR(u32x4, dst) = y1;
          *GPTR(u32x4, dst + 64) = y2;
        }
      }
    } else {
      _Pragma("unroll") for (int ai = 0; ai < 2; ++ai) _Pragma("unroll") for (int bj = 0; bj < 2; ++bj) {
        SCHED;
        _Pragma("unroll") for (int m = 0; m < 4; ++m) _Pragma("unroll") for (int j = 0; j < 4; ++j) {
          const float rs = rstd_s[lrow0 + ai * HALF + m * 16 + fq * 4 + j];
          _Pragma("unroll") for (int n = 0; n < 2; ++n) W_WRITE(m, n, j, acc[ai][bj][m][n][j] * rs);
        }
        bfu* dst = g.outb + (long)(wrow0 + ai * HALF) * g.ldo + wcol0 + bj * HALF;
        W_STORE_BF16(dst, g.ldo);
      }
    }
  } else if constexpr (EPI == EPI_GLU) {
    const int tn = bcol >> 8;
    _Pragma("unroll") for (int ai = 0; ai < 2; ++ai) {
      SCHED;
      _Pragma("unroll") for (int m = 0; m < 4; ++m) _Pragma("unroll") for (int j = 0; j < 4; ++j) {
        const float rs = rstd_s[lrow0 + ai * HALF + m * 16 + fq * 4 + j];
        _Pragma("unroll") for (int n = 0; n < 2; ++n) {
          const float gg = acc[ai][0][m][n][j] * rs, uu = acc[ai][1][m][n][j] * rs;
          W_WRITE(m, n, j, siluf_(gg) * uu);
        }
      }
      bfu* dst = g.outb + (long)(wrow0 + ai * HALF) * g.ldo + tn * 128 + (wcol0 - bcol);
      W_STORE_BF16(dst, g.ldo);
    }
  } else {
    _Pragma("unroll") for (int ai = 0; ai < 2; ++ai) {
      float ssp[8];
      _Pragma("unroll") for (int ps = 0; ps < 8; ++ps) ssp[ps] = 0.f;
      _Pragma("unroll") for (int bj = 0; bj < 2; ++bj) {
        SCHED;
        _Pragma("unroll") for (int m = 0; m < 4; ++m) _Pragma("unroll") for (int j = 0; j < 4; ++j)
          _Pragma("unroll") for (int n = 0; n < 2; ++n) W_WRITE(m, n, j, acc[ai][bj][m][n][j]);
        const long obase = (long)(wrow0 + ai * HALF + (lane >> 3)) * 1024 + wcol0 + bj * HALF + (lane & 7) * 4;
        if (g.res_bf16) {
          u32x2 hrv[8];
          _Pragma("unroll") for (int ps = 0; ps < 8; ++ps) hrv[ps] = *GPTR(const u32x2, g.hb + obase + (long)ps * 8 * 1024);
          _Pragma("unroll") for (int ps = 0; ps < 8; ++ps) {
            const int r_ = ps * 8 + (lane >> 3), c_ = (lane & 7) * 4;
            float4 v = *(const float4*)(W + r_ * 36 + c_);
            v.x += __uint_as_float(hrv[ps][0] << 16); v.y += __uint_as_float(hrv[ps][0] & 0xffff0000u);
            v.z += __uint_as_float(hrv[ps][1] << 16); v.w += __uint_as_float(hrv[ps][1] & 0xffff0000u);
            u32x2 hb2; hb2[0] = pack2(v.x, v.y); hb2[1] = pack2(v.z, v.w);
            *GPTR(u32x2, g.hb + obase + (long)ps * 8 * 1024) = hb2;
            ssp[ps] += v.x * v.x + v.y * v.y + v.z * v.z + v.w * v.w;
          }
        } else {
          _Pragma("unroll") for (int ps = 0; ps < 8; ++ps) {
            const int r_ = ps * 8 + (lane >> 3), c_ = (lane & 7) * 4;
            const long o = obase + (long)ps * 8 * 1024;
            float4 v = *(const float4*)(W + r_ * 36 + c_);
            const f32x4 hr = *GPTR(const f32x4, g.hres + o);
            v.x += hr[0]; v.y += hr[1]; v.z += hr[2]; v.w += hr[3];
            u32x2 hb2; hb2[0] = pack2(v.x, v.y); hb2[1] = pack2(v.z, v.w);
            *GPTR(u32x2, g.hb + o) = hb2;
            ssp[ps] += v.x * v.x + v.y * v.y + v.z * v.z + v.w * v.w;
          }
        }
      }
      _Pragma("unroll") for (int ps = 0; ps < 8; ++ps) {
        float ss = ssp[ps];
        ss += SHX(ss, 1); ss += SHX(ss, 2); ss += SHX(ss, 4);
        if ((lane & 7) == 0) *GPTR(float, g.rowss_next + (long)(wrow0 + ai * HALF + ps * 8 + (lane >> 3)) * 16 + (bcol >> 8) * 4 + wc) = ss;
      }
    }
  }
}

template <int EPI>
__device__ void gemm_phase(const GemmArgs& g, int nM, int nN, int extra_items, const Params& p, int L);

__device__ __forceinline__ int remap_block(int b, int G) { return (G % 8 == 0) ? ((b & 7) * (G >> 3) + (b >> 3)) : b; }

__device__ void ba_item(const Params& p, int L, int rp) {
  const float* misc = (const float*)(p.ws + MISC_OFF);
  float* miscw = (float*)(p.ws + MISC_OFF);
  const bfu* hb = (const bfu*)(p.ws + HB_OFF);
  const float* wba = misc + MF_WBA + (L >> 1) * 8192;
  const float* rowss = misc + MF_RSP + (L == 0 ? 0L : 2L * MTOK * 16);
  int tid = ptid_(p.tid); asm volatile("" : "+v"(tid));
  const int wid = tid >> 6, lane = tid & 63;
  f32x4 wr_[8][4];
  _Pragma("unroll") for (int j = 0; j < 8; ++j) _Pragma("unroll") for (int e4 = 0; e4 < 4; ++e4)
    wr_[j][e4] = *(const f32x4*)(wba + j * 1024 + lane * 16 + e4 * 4);
  for (int bt = 0; bt < 8; ++bt) {
    bf16x8 h0[2], h1[2]; f32x4 ps[2][4];
    _Pragma("unroll") for (int u = 0; u < 2; ++u) {
      const int row = rp * 128 + wid * 16 + bt * 2 + u;
      const bfu* hr = hb + (long)row * 1024 + lane * 16;
      h0[u] = *(const bf16x8*)hr; h1[u] = *(const bf16x8*)(hr + 8);
      _Pragma("unroll") for (int i = 0; i < 4; ++i) ps[u][i] = *(const f32x4*)(rowss + (long)row * 16 + i * 4);
    }
    _Pragma("unroll") for (int u = 0; u < 2; ++u) {
      const int row = rp * 128 + wid * 16 + bt * 2 + u;
      float hf[16];
      _Pragma("unroll") for (int e = 0; e < 8; ++e) { hf[e] = bf2f((bfu)h0[u][e]); hf[8 + e] = bf2f((bfu)h1[u][e]); }
      float a[8];
      _Pragma("unroll") for (int j = 0; j < 8; ++j) {
        float s = 0.f;
        _Pragma("unroll") for (int e4 = 0; e4 < 4; ++e4) _Pragma("unroll") for (int e = 0; e < 4; ++e) s += hf[e4 * 4 + e] * wr_[j][e4][e];
        _Pragma("unroll") for (int o = 32; o >= 1; o >>= 1) s += SHX(s, o);
        a[j] = s;
      }
      if (lane < 8) {
        float s16 = 0.f;
        _Pragma("unroll") for (int i = 0; i < 4; ++i) s16 += (ps[u][i][0] + ps[u][i][1]) + (ps[u][i][2] + ps[u][i][3]);
        float rs = frsq(s16 * (1.0f / 1024.0f) + 1e-6f);
        float v = 0.f;
        _Pragma("unroll") for (int j = 0; j < 8; ++j) if (lane == j) v = a[j];
        v *= rs;
        float r;
        if (lane < 4) r = sigmoidf_(v);
        else {
          int hh = lane - 4;
          float z = v + p.dn_dt_bias[(L >> 1) * 4 + hh];
          float sp = (z > 20.f) ? z : flog(1.0f + fexp(z));
          r = -fexp(p.dn_a_log[(L >> 1) * 4 + hh]) * sp;
        }
        miscw[MF_BG + (long)row * 8 + lane] = r;
      }
    }
  }
}

template <int EPI>
__device__ void gemm_phase(const GemmArgs& g, int nM, int nN, int extra_items, const Params& p, int L) {
  const int G = gridDim.x;
  const int total = nM * nN;
  const int rb = remap_block(p.bid, G);
  int par = 0;
  bool have = false;
  for (int v = rb; v < total + extra_items; v += G) {
    if (v < total) {
      const int nig = 8 * nN;
      int pm = (v / nig) * 8 + ((v % nig) & 7), pn = (v % nig) >> 3;
      const int nv = v + G; const bool nvalid = nv < total;
      const int npm = (nv / nig) * 8 + ((nv % nig) & 7), npn = (nv % nig) >> 3;
      gemm_tile<EPI>(g, pm * BM, pn * BM, par++, !have, nvalid, npm * BM, npn * BM);
      have = nvalid;
    } else {
      ba_item(p, L, v - total);
    }
  }
}

struct CvtJob { const float* src0; const float* src1; int ld; int kind; const float* gain; long dst; int N; int K; };

__device__ CvtJob get_job(const Params& p, int L, int j) {
  CvtJob c{}; int i = L >> 1; long base = wt_base(L);
  if ((L & 1) == 0) {
    if (j == 0) { c.src0 = p.ab_w_in + (long)i * 1024 * 3592; c.ld = 3592; c.kind = 1; c.gain = p.norm_mix_g + L * 1024; c.dst = base; c.N = 3584; c.K = 1024; }
    else if (j == 1) { c.src0 = p.ab_w_out + (long)i * 1024 * 1024; c.ld = 1024; c.kind = 0; c.gain = nullptr; c.dst = base + 3584L * 1024; c.N = 1024; c.K = 1024; }
    else if (j == 2) { c.src0 = p.ffn_w_gate + (long)L * 1024 * 2816; c.src1 = p.ffn_w_up + (long)L * 1024 * 2816; c.ld = 2816; c.kind = 3; c.gain = p.norm_ffn_g + L * 1024; c.dst = base + 4608L * 1024; c.N = 5632; c.K = 1024; }
    else if (j == 3) { c.src0 = p.ffn_w_down + (long)L * 2816 * 1024; c.ld = 1024; c.kind = 0; c.gain = nullptr; c.dst = base + 10240L * 1024; c.N = 1024; c.K = 2816; }
    else { c.N = 0; c.K = 64; }
  } else {
    if (j == 0) { c.src0 = p.cd_w_in + (long)i * 1024 * 6656; c.ld = 6656; c.kind = 2; c.gain = p.norm_mix_g + L * 1024; c.dst = base; c.N = 4608; c.K = 1024; }
    else if (j == 1) { c.src0 = p.cd_w_in + (long)i * 1024 * 6656; c.ld = 6656; c.kind = 0; c.gain = p.norm_mix_g + L * 1024; c.dst = base + 4608L * 1024; c.N = 2048; c.K = 1024; }
    else if (j == 2) { c.src0 = p.cd_w_out + (long)i * 1024 * 1024; c.ld = 1024; c.kind = 0; c.gain = nullptr; c.dst = base + 6656L * 1024; c.N = 1024; c.K = 1024; }
    else if (j == 3) { c.src0 = p.ffn_w_gate + (long)L * 1024 * 2816; c.src1 = p.ffn_w_up + (long)L * 1024 * 2816; c.ld = 2816; c.kind = 3; c.gain = p.norm_ffn_g + L * 1024; c.dst = base + 7680L * 1024; c.N = 5632; c.K = 1024; }
    else { c.src0 = p.ffn_w_down + (long)L * 2816 * 1024; c.ld = 1024; c.kind = 0; c.gain = nullptr; c.dst = base + 13312L * 1024; c.N = 1024; c.K = 2816; }
  }
  return c;
}

__device__ void cvt_tile(const CvtJob& c, int tile, bfu* wt, const int tid_) {
  float* ts = (float*)smem;
  const int nk = c.K / 256;
  const int tn = tile / nk, tk = tile % nk;
  const int n0 = tn * 64, k0 = tk * 256;
  const float* src = c.src0; int l0;
  if (c.kind == 0) l0 = n0;
  else if (c.kind == 1) l0 = (n0 < 2048) ? n0 : n0 + 8;
  else if (c.kind == 2) {
    if (n0 < 3072) { int tl = n0 >> 8, w = n0 & 255, bj = w >> 7, hsel = (w & 127) >> 6; l0 = 2048 + tl * 256 + hsel * 128 + bj * 64; }
    else l0 = 2048 + n0;
  } else { int tl = n0 >> 8, w = n0 & 255; src = (w < 128) ? c.src0 : c.src1; l0 = tl * 128 + (w & 127); }
  const int tid = tid_;
  __syncthreads();
  { f32x4 v[8];
    _Pragma("unroll") for (int i = 0; i < 8; ++i) { const int idx = tid + 512 * i; const int kk = idx >> 4, n4 = idx & 15;
      v[i] = *GPTR(const f32x4, src + (long)(k0 + kk) * c.ld + l0 + n4 * 4); }
    _Pragma("unroll") for (int i = 0; i < 8; ++i) { const int idx = tid + 512 * i; const int kk = idx >> 4, n4 = idx & 15;
      const float gsc = c.gain ? c.gain[k0 + kk] : 1.0f;
      _Pragma("unroll") for (int e = 0; e < 4; ++e) ts[kk * 65 + n4 * 4 + e] = v[i][e] * gsc; } }
  __syncthreads();
  { _Pragma("unroll") for (int i = 0; i < 4; ++i) { const int idx = tid + 512 * i;
      const int ch = ((idx >> 6) & 3) * 8 + (idx & 7), n = (idx >> 8) * 8 + ((idx >> 3) & 7);
      u32x4 o_;
      _Pragma("unroll") for (int e = 0; e < 4; ++e) o_[e] = pack2(ts[(ch * 8 + 2 * e) * 65 + n], ts[(ch * 8 + 2 * e + 1) * 65 + n]);
      *GPTR(u32x4, wt + c.dst + (long)(n0 + n) * c.K + k0 + ch * 8) = o_; } }
}
__device__ void cvt_jobs(const Params& p, int L0, int j0, int L1, int j1, int vb, int VG) {
  bfu* wt = (bfu*)(p.ws + WT_OFF);
  int tbase = 0;
  for (int L = L0; L <= L1; ++L) {
    const int ja = (L == L0) ? j0 : 0, jb = (L == L1) ? j1 : 4;
    for (int j = ja; j <= jb; ++j) {
      CvtJob c = get_job(p, L, j);
      int ntile = (c.N / 64) * (c.K / 256);
      int first = ((vb - tbase) % VG + VG) % VG;
      for (int t = first; t < ntile; t += VG) cvt_tile(c, t, wt, ptid_(p.tid));
      tbase = (tbase + ntile) % VG;
    }
  }
}

__device__ void phase_prologue(const Params& p) {
  float* misc = (float*)(p.ws + MISC_OFF);
  bfu* hb = (bfu*)(p.ws + HB_OFF);
  const int G = gridDim.x, tid = ptid_(p.tid), wid = tid >> 6, lane = tid & 63;
  const long gtid = (long)p.bid * NTHR + tid, gstride = (long)G * NTHR;

  for (long i = gtid; i < 1024; i += gstride) {
    int li = (int)(i >> 9), c = (int)(i & 511);
    float a = p.hg_lb[c], b = p.hg_lb[512 + c];
    float mx = fmaxf(a, b); float ea = fexp(a - mx), eb = fexp(b - mx);
    misc[MF_LB + i] = (li == 0) ? 0.f : eb * frcp(ea + eb);
  }
  for (long i = gtid; i < 16384; i += gstride) {
    int li = (int)(i >> 13), j = (int)((i >> 10) & 7), k = (int)(i & 1023);
    misc[MF_WBA + i] = p.norm_mix_g[(2 * li) * 1024 + k] * p.ab_w_in[(long)li * 1024 * 3592 + (long)k * 3592 + 2048 + j];
  }
  for (long i = gtid; i < (long)TSEQ * 64; i += gstride) {
    int t = (int)(i >> 6), dd = (int)(i & 63);
    float invf = __builtin_amdgcn_exp2f(-(float)dd * (13.287712379549449f / 64.0f));
    if (dd == 0) invf = 1.0f;
    double rev = (double)t * (double)invf * 0.15915494309189535;
    float fr = (float)(rev - floor(rev));
    misc[MF_ROPE + i] = __builtin_amdgcn_cosf(fr);
    misc[MF_ROPE + TSEQ * 64 + i] = __builtin_amdgcn_sinf(fr);
  }
  for (int row = p.bid * 8 + wid; row < MTOK; row += G * 8) {
    const float* xr = p.x + (long)row * 1024 + lane * 16;
    float4 a0 = *(const float4*)xr, a1 = *(const float4*)(xr + 4), a2 = *(const float4*)(xr + 8), a3 = *(const float4*)(xr + 12);
    float ss = a0.x * a0.x + a0.y * a0.y + a0.z * a0.z + a0.w * a0.w + a1.x * a1.x + a1.y * a1.y + a1.z * a1.z + a1.w * a1.w +
               a2.x * a2.x + a2.y * a2.y + a2.z * a2.z + a2.w * a2.w + a3.x * a3.x + a3.y * a3.y + a3.z * a3.z + a3.w * a3.w;
    uint4 o0, o1;
    o0.x = pack2(a0.x, a0.y); o0.y = pack2(a0.z, a0.w); o0.z = pack2(a1.x, a1.y); o0.w = pack2(a1.z, a1.w);
    o1.x = pack2(a2.x, a2.y); o1.y = pack2(a2.z, a2.w); o1.z = pack2(a3.x, a3.y); o1.w = pack2(a3.z, a3.w);
    *(uint4*)(hb + (long)row * 1024 + lane * 16) = o0;
    *(uint4*)(hb + (long)row * 1024 + lane * 16 + 8) = o1;
    for (int o = 32; o >= 1; o >>= 1) ss += SHX(ss, o);
    if (lane < 16) misc[MF_RSP + (long)row * 16 + lane] = (lane == 0) ? ss : 0.f;
  }
  cvt_jobs(p, 0, 0, 0, 0, p.bid, G);
}

__device__ __forceinline__ int fragA_128(int r, int k) { return ((r >> 4) * 4 + (k >> 5)) * 512 + ((k >> 3) & 3) * 128 + (r & 15) * 8 + (k & 7); }
__device__ __forceinline__ int fragA_64(int r, int k) { return ((r >> 4) * 2 + (k >> 5)) * 512 + ((k >> 3) & 3) * 128 + (r & 15) * 8 + (k & 7); }
__device__ __forceinline__ int fragC_128(int r, int cidx) { return ((r >> 4) * 8 + (cidx >> 4)) * 256 + (((r & 15) >> 2)) * 64 + (cidx & 15) * 4 + (r & 3); }
__device__ __forceinline__ bfu* dnp_item(const Params& p, int idx) {
  return (idx < 1820) ? ((bfu*)p.out + (long)idx * 36864) : ((bfu*)(p.ws + R_OFF) + (long)(idx - 1820) * 36864);
}
__device__ void dn_pre_item(const Params& p, int L, int idx) {
  const int li = L >> 1;
  float* misc = (float*)(p.ws + MISC_OFF);
  const bfu* pab = (const bfu*)(p.ws + PAB_OFF);
  bfu* dnp = dnp_item(p, idx);
  const int b = idx >> 8, h = (idx >> 6) & 3, n = idx & 63;
  const long R0 = (long)b * TSEQ + n * 64;
  int zoff = 0; asm volatile("" : "+v"(zoff));
  unsigned char* sb = smem + zoff;
  float* As = (float*)sb; float* gcs = As + 64 * 65; float* betas = gcs + 64; float* egc = betas + 64;
  float* qs = (float*)(sb + 17408); float* ks = (float*)(sb + 51200); float* vs = (float*)(sb + 84992);
  bfu* kb = (bfu*)(sb + 118784); bfu* qb = (bfu*)(sb + 136192);
  float* Tf = (float*)(sb + 17408); bfu* Tb = (bfu*)(sb + 34048); float* Mt = (float*)(sb + 43264);
  bfu* rhsT = (bfu*)(sb + 118784);
  int tid = ptid_(p.tid); asm volatile("" : "+v"(tid)); const int wid = tid >> 6, lane = tid & 63;
  const int c16 = lane & 15, q4 = lane >> 4;
  __syncthreads();
  float gv_pre = 0.f, be_pre = 0.f;
  if (wid == 0) { gv_pre = misc[MF_BG + (R0 + lane) * 8 + 4 + h]; be_pre = misc[MF_BG + (R0 + lane) * 8 + h]; }
  { const int c = tid & 127, rg = tid >> 7;
    const int r0 = rg * 16;
    const bool head0 = (n == 0) && (rg == 0);
    bfu xr[3][19]; float cwv[3][4];
    _Pragma("unroll") for (int mat = 0; mat < 3; ++mat) {
      const int colp = mat * 512 + h * 128 + c;
      const float* cw = p.dn_conv_w + (long)li * 4 * 1536 + colp;
      _Pragma("unroll") for (int jw = 0; jw < 4; ++jw) cwv[mat][jw] = cw[jw * 1536];
      _Pragma("unroll") for (int i = 0; i < 19; ++i) {
        const long rr = R0 + r0 - 3 + i;
        xr[mat][i] = pab[((i < 3 && head0) ? R0 : rr) * 3584 + colp];
      }
    }
    _Pragma("unroll") for (int mat = 0; mat < 3; ++mat) {
      float* dst = (mat == 0) ? qs : (mat == 1 ? ks : vs);
      float xm3 = head0 ? 0.f : bf2f(xr[mat][0]), xm2 = head0 ? 0.f : bf2f(xr[mat][1]), xm1 = head0 ? 0.f : bf2f(xr[mat][2]);
      _Pragma("unroll") for (int r = 0; r < 16; ++r) {
        const float x0 = bf2f(xr[mat][3 + r]);
        const float y = cwv[mat][0] * xm3 + cwv[mat][1] * xm2 + cwv[mat][2] * xm1 + cwv[mat][3] * x0;
        dst[(r0 + r) * 132 + c] = siluf_(y);
        xm3 = xm2; xm2 = xm1; xm1 = x0;
      }
    }
  }
  __syncthreads();
  { const int rowid = tid >> 2, part = tid & 3;
    const bool isq = rowid < 64; const int rr = isq ? rowid : rowid - 64;
    float* base = (isq ? qs : ks) + rr * 132;
    bfu* bb = (isq ? qb : kb) + rr * 136;
    float ss = 0.f;
    for (int i = 0; i < 32; ++i) { float v = base[part + 4 * i]; ss += v * v; }
    ss += SHX(ss, 1); ss += SHX(ss, 2);
    float sc = frsq(ss + 1e-6f) * (isq ? 0.08838834764831845f : 1.0f);
    for (int i = 0; i < 32; ++i) { float v = base[part + 4 * i] * sc; base[part + 4 * i] = v; bb[part + 4 * i] = f2bf(v); }
  }
  if (wid == 0) {
    float gv = gv_pre;
    for (int o = 1; o < 64; o <<= 1) { float t = shup_(gv, o, lane); if (lane >= o) gv += t; }
    gcs[lane] = gv; egc[lane] = fexp(gv);
    betas[lane] = be_pre;
  }
  __syncthreads();
  for (int i = 0; i < 4; ++i) {
    const int id = wid * 4 + i; const int mat = id >> 4, rt = (id & 15) >> 2, ct = id & 3;
    f32x4 a = (f32x4){0.f, 0.f, 0.f, 0.f};
    if (ct <= rt) {
      _Pragma("unroll") for (int kk = 0; kk < 4; ++kk) {
        bf16x8 rf = *(const bf16x8*)((mat == 0 ? kb : qb) + (rt * 16 + c16) * 136 + kk * 32 + q4 * 8);
        bf16x8 cf = *(const bf16x8*)(kb + (ct * 16 + c16) * 136 + kk * 32 + q4 * 8);
        if (mat == 0) a = __builtin_amdgcn_mfma_f32_16x16x32_bf16(rf, cf, a, 0, 0, 0);
        else a = __builtin_amdgcn_mfma_f32_16x16x32_bf16(cf, rf, a, 0, 0, 0);
      }
    }
    if (mat == 0) {
      const int s = ct * 16 + c16;
      _Pragma("unroll") for (int j = 0; j < 4; ++j) {
        const int row = rt * 16 + q4 * 4 + j;
        float dec = (s <= row) ? fexp(gcs[row] - gcs[s]) : 0.f;
        As[row * 65 + s] = (s < row) ? betas[row] * a[j] * dec : 0.f;
      }
    } else {
      const int row = rt * 16 + c16; const int s0 = ct * 16 + q4 * 4;
      float v[4];
      _Pragma("unroll") for (int j = 0; j < 4; ++j) { const int s = s0 + j; v[j] = (s <= row) ? a[j] * fexp(gcs[row] - gcs[s]) : 0.f; }
      u32x2 o2; o2[0] = pack2(v[0], v[1]); o2[1] = pack2(v[2], v[3]);
      *(u32x2*)(dnp + 32768 + (rt * 2 + (s0 >> 5)) * 512 + ((s0 >> 3) & 3) * 128 + c16 * 8 + (s0 & 7)) = o2;
    }
  }
  _Pragma("unroll") for (int i2 = 0; i2 < 2; ++i2) {
    const int blk = wid + 8 * i2;
    { const int rt = blk >> 2, kk = blk & 3; const int row = rt * 16 + c16, k = kk * 32 + q4 * 8;
      const float4 x0 = *(const float4*)(qs + row * 132 + k), x1 = *(const float4*)(qs + row * 132 + k + 4);
      const float eg = egc[row];
      u32x4 o4; o4[0] = pack2(x0.x * eg, x0.y * eg); o4[1] = pack2(x0.z * eg, x0.w * eg); o4[2] = pack2(x1.x * eg, x1.y * eg); o4[3] = pack2(x1.z * eg, x1.w * eg);
      *(u32x4*)(dnp + 16384 + blk * 512 + lane * 8) = o4; }
    { const int dt = blk >> 1, k2 = blk & 1; const int d = dt * 16 + c16, s0 = k2 * 32 + q4 * 8;
      float v[8];
      _Pragma("unroll") for (int e = 0; e < 8; ++e) v[e] = ks[(s0 + e) * 132 + d] * fexp(gcs[63] - gcs[s0 + e]);
      u32x4 o4; o4[0] = pack2(v[0], v[1]); o4[1] = pack2(v[2], v[3]); o4[2] = pack2(v[4], v[5]); o4[3] = pack2(v[6], v[7]);
      *(u32x4*)(dnp + 24576 + blk * 512 + lane * 8) = o4; }
  }
  if (tid == 0) misc[MF_GTOT + idx] = egc[63];
  __syncthreads();
  if (wid == 0) {
    const int blk = lane >> 5, j = lane & 31;
    const float* Ab = As + (blk * 32) * 65 + blk * 32;
    float x[32];
#pragma unroll
    for (int c = 0; c < 32; ++c) {
      float r = (c == j) ? 1.0f : 0.0f;
#pragma unroll
      for (int s = 0; s < c; ++s) r -= Ab[c * 65 + s] * x[s];
      x[c] = r;
    }
#pragma unroll
    for (int c = 0; c < 32; ++c) Tf[(blk * 32 + c) * 65 + blk * 32 + j] = x[c];
  } else {
    for (int e = tid - 64; e < 16384; e += 448) {
      const int col = e >> 6, s = e & 63;
      float v = (col < 128) ? betas[s] * vs[s * 132 + col] : betas[s] * egc[s] * ks[s * 132 + (col - 128)];
      rhsT[col * 72 + s] = f2bf(v);
    }
  }
  __syncthreads();
  { const int i = tid >> 4, j0 = (tid & 15) * 2;
    float m0 = 0.f, m1 = 0.f;
    for (int k = 0; k < 32; ++k) { float av = As[(32 + i) * 65 + k]; m0 += av * Tf[k * 65 + j0]; m1 += av * Tf[k * 65 + j0 + 1]; }
    Mt[i * 33 + j0] = m0; Mt[i * 33 + j0 + 1] = m1;
  }
  __syncthreads();
  { const int i = tid >> 4, j0 = (tid & 15) * 2;
    float t0 = 0.f, t1 = 0.f;
    for (int k = 0; k < 32; ++k) { float tv = Tf[(32 + i) * 65 + 32 + k]; t0 += tv * Mt[k * 33 + j0]; t1 += tv * Mt[k * 33 + j0 + 1]; }
    Tb[(32 + i) * 72 + j0] = f2bf(-t0); Tb[(32 + i) * 72 + j0 + 1] = f2bf(-t1);
    Tb[i * 72 + j0] = f2bf(Tf[i * 65 + j0]); Tb[i * 72 + j0 + 1] = f2bf(Tf[i * 65 + j0 + 1]);
    Tb[i * 72 + 32 + j0] = 0; Tb[i * 72 + 32 + j0 + 1] = 0;
    Tb[(32 + i) * 72 + 32 + j0] = f2bf(Tf[(32 + i) * 65 + 32 + j0]); Tb[(32 + i) * 72 + 32 + j0 + 1] = f2bf(Tf[(32 + i) * 65 + 32 + j0 + 1]);
  }
  __syncthreads();
  { bf16x8 tf[4][2];
    _Pragma("unroll") for (int rt = 0; rt < 4; ++rt) _Pragma("unroll") for (int k2 = 0; k2 < 2; ++k2)
      tf[rt][k2] = *(const bf16x8*)(Tb + (rt * 16 + c16) * 72 + k2 * 32 + q4 * 8);
    _Pragma("unroll") for (int cc = 0; cc < 2; ++cc) {
      const int ct = wid * 2 + cc;
      bf16x8 bf[2];
      _Pragma("unroll") for (int k2 = 0; k2 < 2; ++k2) bf[k2] = *(const bf16x8*)(rhsT + (ct * 16 + c16) * 72 + k2 * 32 + q4 * 8);
      _Pragma("unroll") for (int rt = 0; rt < 4; ++rt) {
        f32x4 a = (f32x4){0.f, 0.f, 0.f, 0.f};
        if (ct < 8) {
          _Pragma("unroll") for (int k2 = 0; k2 < 2; ++k2) a = __builtin_amdgcn_mfma_f32_16x16x32_bf16(tf[rt][k2], bf[k2], a, 0, 0, 0);
          u32x2 o2; o2[0] = pack2(a[0], a[1]); o2[1] = pack2(a[2], a[3]);
          *(u32x2*)(dnp + 8192 + ((rt * 8 + ct) * 64 + lane) * 4) = o2;
        } else {
          _Pragma("unroll") for (int k2 = 0; k2 < 2; ++k2) a = __builtin_amdgcn_mfma_f32_16x16x32_bf16(bf[k2], tf[rt][k2], a, 0, 0, 0);
          const int k0 = (ct - 8) * 16 + q4 * 4;
          u32x2 o2; o2[0] = pack2(-a[0], -a[1]); o2[1] = pack2(-a[2], -a[3]);
          *(u32x2*)(dnp + (rt * 4 + (k0 >> 5)) * 512 + ((k0 >> 3) & 3) * 128 + c16 * 8 + (k0 & 7)) = o2;
        }
      }
    }
  }
}

__device__ void dn_scan_block(const Params& p, int L, int item) {
  float* misc = (float*)(p.ws + MISC_OFF);
  bfu* pab = (bfu*)(p.ws + PAB_OFF);
  const int bh = item >> 2, qt = item & 3;

  int tid = ptid_(p.tid); asm volatile("" : "+v"(tid));
  const int w = tid >> 6, lane = tid & 63, c = lane & 15, q = lane >> 4;
  const int rt = w >> 1, ct = w & 1, dt = w;
  bfu* St = (bfu*)smem;
  bfu* ut = St + 2 * 2176;
  const int b = bh >> 2, h = bh & 3;
  __syncthreads();
  for (int i = tid; i < 2 * 2176; i += NTHR) St[i] = 0;
  f32x4 Sacc[2];
  Sacc[0] = (f32x4){0.f, 0.f, 0.f, 0.f}; Sacc[1] = Sacc[0];
#define DN_DECL(X) bf16x8 nw##X[4], qd##X[4], qk##X[2], kd##X[2]; float ub##X[4]; float gt##X;
  DN_DECL(A) DN_DECL(B) DN_DECL(C)
#define DN_LOAD(X, nn) do { const bfu* cb0 = dnp_item(p, bh * 64 + (nn)); const bfu* cb = cb0 + lane * 8; \
    _Pragma("unroll") for (int kk = 0; kk < 4; ++kk) { nw##X[kk] = *(const bf16x8*)(cb + (rt * 4 + kk) * 512); \
                                 qd##X[kk] = *(const bf16x8*)(cb + 16384 + (rt * 4 + kk) * 512); } \
    _Pragma("unroll") for (int k2 = 0; k2 < 2; ++k2) { qk##X[k2] = *(const bf16x8*)(cb + 32768 + (rt * 2 + k2) * 512); \
                                 kd##X[k2] = *(const bf16x8*)(cb + 24576 + (dt * 2 + k2) * 512); } \
    { const u32x2 uu = *(const u32x2*)(cb0 + 8192 + ((rt * 8 + qt * 2 + ct) * 64 + lane) * 4); \
      ub##X[0] = bf2f((bfu)(uu[0] & 0xffffu)); ub##X[1] = bf2f((bfu)(uu[0] >> 16)); ub##X[2] = bf2f((bfu)(uu[1] & 0xffffu)); ub##X[3] = bf2f((bfu)(uu[1] >> 16)); } \
    gt##X = misc[MF_GTOT + bh * 64 + (nn)]; } while (0)
#define DN_STEP(X, n) do { \
    bf16x8 bS[4]; \
    _Pragma("unroll") for (int kk = 0; kk < 4; ++kk) bS[kk] = *(const bf16x8*)(St + ct * 2176 + c * 136 + kk * 32 + q * 8); \
    f32x4 u, o; \
    _Pragma("unroll") for (int j = 0; j < 4; ++j) u[j] = ub##X[j]; \
    o = (f32x4){0.f, 0.f, 0.f, 0.f}; \
    _Pragma("unroll") for (int kk = 0; kk < 4; ++kk) { \
      u = __builtin_amdgcn_mfma_f32_16x16x32_bf16(nw##X[kk], bS[kk], u, 0, 0, 0); \
      o = __builtin_amdgcn_mfma_f32_16x16x32_bf16(qd##X[kk], bS[kk], o, 0, 0, 0); } \
    { uint2 uo; uo.x = pack2(u[0], u[1]); uo.y = pack2(u[2], u[3]); \
      *(uint2*)(ut + ct * 1152 + c * 72 + rt * 16 + q * 4) = uo; } \
    LBAR; \
    bf16x8 bU[2][2]; \
    _Pragma("unroll") for (int cc = 0; cc < 2; ++cc) _Pragma("unroll") for (int k2 = 0; k2 < 2; ++k2) \
      bU[cc][k2] = *(const bf16x8*)(ut + cc * 1152 + c * 72 + k2 * 32 + q * 8); \
    _Pragma("unroll") for (int k2 = 0; k2 < 2; ++k2) { \
      bf16x8 bsel = *(const bf16x8*)(ut + ct * 1152 + c * 72 + k2 * 32 + q * 8); \
      o = __builtin_amdgcn_mfma_f32_16x16x32_bf16(qk##X[k2], bsel, o, 0, 0, 0); } \
    _Pragma("unroll") for (int j = 0; j < 4; ++j) { \
      long row = (long)b * TSEQ + (n) * 64 + rt * 16 + q * 4 + j; \
      pab[row * 3584 + h * 128 + qt * 32 + ct * 16 + c] = f2bf(o[j]); } \
    _Pragma("unroll") for (int cc = 0; cc < 2; ++cc) { \
      f32x4 a = Sacc[cc] * gt##X; \
      _Pragma("unroll") for (int k2 = 0; k2 < 2; ++k2) a = __builtin_amdgcn_mfma_f32_16x16x32_bf16(kd##X[k2], bU[cc][k2], a, 0, 0, 0); \
      Sacc[cc] = a; \
      uint2 so; so.x = pack2(a[0], a[1]); so.y = pack2(a[2], a[3]); \
      *(uint2*)(St + cc * 2176 + c * 136 + dt * 16 + q * 4) = so; } \
    LBAR; } while (0)
  DN_LOAD(A, 0); DN_LOAD(B, 1);
  __syncthreads();
  for (int n = 0; n < 63; n += 3) {
    DN_LOAD(C, n + 2); DN_STEP(A, n);
    DN_LOAD(A, n + 3); DN_STEP(B, n + 1);
    if (n + 4 < 64) DN_LOAD(B, n + 4);
    DN_STEP(C, n + 2);
  }
  DN_STEP(A, 63);
}

__device__ void ab_fin_rows(const Params& p, int L, int row0, int nrows, const bool doA, const bool doB) {
  const int li = L >> 1;
  bfu* pab = (bfu*)(p.ws + PAB_OFF);
  int tid = ptid_(p.tid); asm volatile("" : "+v"(tid)); const int wid = tid >> 6, lane = tid & 63;
  for (int rr = wid; rr < nrows; rr += 8) {
    const long row = row0 + rr;
    const int t = (int)(row & (TSEQ - 1));
    bfu* pr = pab + row * 3584;
    const int c0 = lane * 8;
    if (doA) {
    bf16x8 o = *(const bf16x8*)(pr + c0);
    bf16x8 z = *(const bf16x8*)(pr + 1536 + c0);
    float of[8]; float ss = 0.f;
    for (int e = 0; e < 8; ++e) { of[e] = bf2f((bfu)o[e]); ss += of[e] * of[e]; }
    ss += SHX(ss, 1); ss += SHX(ss, 2); ss += SHX(ss, 4); ss += SHX(ss, 8);
    const float rs = frsq(ss * (1.0f / 128.0f) + 1e-6f);
    float ra[8];
    for (int e = 0; e < 8; ++e) ra[e] = of[e] * rs * p.dn_norm_g[li * 128 + ((c0 + e) & 127)] * siluf_(bf2f((bfu)z[e]));
    uint4 wa; wa.x = pack2(ra[0], ra[1]); wa.y = pack2(ra[2], ra[3]); wa.z = pack2(ra[4], ra[5]); wa.w = pack2(ra[6], ra[7]);
    *(uint4*)(pr + 512 + c0) = wa;
    }
    if (doB) {
    bf16x8 gb = *(const bf16x8*)(pr + 2048 + c0);
    float rb[8];
    for (int e = 0; e < 8; ++e) rb[e] = 0.f;
    for (int j = 0; j < 3; ++j) {
      int tt = t - 2 + j;
      if (tt >= 0) {
        const bfu* pj = pab + (row - 2 + j) * 3584;
        bf16x8 gc = *(const bf16x8*)(pj + 2560 + c0);
        bf16x8 si = *(const bf16x8*)(pj + 3072 + c0);
        for (int e = 0; e < 8; ++e) rb[e] += p.sc_conv_w[(long)li * 3 * 512 + j * 512 + c0 + e] * (bf2f((bfu)gc[e]) * bf2f((bfu)si[e]));
      }
    }
    for (int e = 0; e < 8; ++e) rb[e] *= bf2f((bfu)gb[e]);
    uint4 wb; wb.x = pack2(rb[0], rb[1]); wb.y = pack2(rb[2], rb[3]); wb.z = pack2(rb[4], rb[5]); wb.w = pack2(rb[6], rb[7]);
    *(uint4*)(pr + 1024 + c0) = wb;
    }
  }
}

__device__ void swa_item(const Params& p, int item) {
  float* misc = (float*)(p.ws + MISC_OFF);
  bfu* buf = (bfu*)(p.ws + R_OFF);
  const int pat = item >> 10; const int rem = item & 1023;
  const int b = rem >> 7, head = (rem >> 5) & 3, sub = rem & 31;
  const int dil = (pat == 0) ? 1 : (pat == 1 ? 4 : 16);
  const int nqb = 32 / dil;
  const int r = sub / nqb, qb = sub % nqb;
  int tid = ptid_(p.tid); asm volatile("" : "+v"(tid)); const int w = tid >> 6, lane = tid & 63, c = lane & 15, q = lane >> 4;
  bfu* Vt = (bfu*)smem;
  bfu* Ks = Vt + 128 * 280;
  bfu* Pl = Ks + w * (16 * 168);
  const long rowb = (long)b * TSEQ;
  const int qcol = pat * 512 + head * 128, kcol = 1536 + qcol, vcol = 3072 + qcol;
  __syncthreads();
  _Pragma("unroll") for (int i = 0; i < 4; ++i) {
    int co = tid + 512 * i; int c8 = co & 15, kp = co >> 4;
    int j0 = qb * 128 - 128 + 2 * kp;
    const int j0c = (j0 >= 0) ? j0 : 0;
    bf16x8 v0 = *(const bf16x8*)(buf + (rowb + (long)j0c * dil + r) * 4608 + vcol + c8 * 8);
    bf16x8 v1 = *(const bf16x8*)(buf + (rowb + (long)(j0c + 1) * dil + r) * 4608 + vcol + c8 * 8);
    if (j0 < 0) { v0 = (bf16x8){0, 0, 0, 0, 0, 0, 0, 0}; v1 = v0; }
    const int chs = ((kp >> 2) ^ c8) * 8 + ((2 * kp) & 7);
    _Pragma("unroll") for (int e = 0; e < 8; ++e)
      *(unsigned*)(Vt + (c8 * 8 + e) * 280 + chs) = (unsigned)(bfu)v0[e] | ((unsigned)(bfu)v1[e] << 16);
  }
  _Pragma("unroll") for (int i = 0; i < 8; ++i) {
    int co = tid + 512 * i; int c8 = co & 15, kj = co >> 4;
    int j = qb * 128 - 128 + kj; j = (j >= 0) ? j : 0;
    *(bf16x8*)(Ks + kj * 136 + c8 * 8) = *(const bf16x8*)(buf + (rowb + (long)j * dil + r) * 4608 + kcol + c8 * 8);
  }
  for (int i = tid; i < 128 * 12; i += NTHR) { int dv = i / 12, k2 = i % 12; *(unsigned*)(Vt + dv * 280 + 256 + 2 * k2) = 0u; }
  bf16x8 qf[4];
  { long qrow = rowb + (long)(qb * 128 + w * 16 + c) * dil + r;
    _Pragma("unroll") for (int kk = 0; kk < 4; ++kk) qf[kk] = *(const bf16x8*)(buf + qrow * 4608 + qcol + kk * 32 + q * 8); }
  __syncthreads();
  f32x4 S[9];
  _Pragma("unroll") for (int ci = 0; ci < 9; ++ci) {
    const int ct = w + ci;
    f32x4 a = (f32x4){0.f, 0.f, 0.f, 0.f};
    _Pragma("unroll") for (int kk = 0; kk < 4; ++kk) {
      bf16x8 kf = *(const bf16x8*)(Ks + (ct * 16 + c) * 136 + kk * 32 + q * 8);
      a = __builtin_amdgcn_mfma_f32_16x16x32_bf16(qf[kk], kf, a, 0, 0, 0);
    }
    S[ci] = a;
  }
  float mx[4], ls[4];
  _Pragma("unroll") for (int jj = 0; jj < 4; ++jj) {
    const int qi = w * 16 + q * 4 + jj;
    float m = -1e30f;
    _Pragma("unroll") for (int ci = 0; ci < 9; ++ci) {
      int kj = (w + ci) * 16 + c; int dist = qi + 128 - kj;
      bool valid = (dist >= 0) && (dist <= 128) && (qb > 0 || kj >= 128);
      float s = valid ? S[ci][jj] : -1e30f;
      S[ci][jj] = s; m = fmaxf(m, s);
    }
    m = fmaxf(m, SHX(m, 1)); m = fmaxf(m, SHX(m, 2)); m = fmaxf(m, SHX(m, 4)); m = fmaxf(m, SHX(m, 8));
    float l = 0.f;
    _Pragma("unroll") for (int ci = 0; ci < 9; ++ci) {
      float s = S[ci][jj];
      float pv = (s > -1e29f) ? fexp(s - m) : 0.f;
      S[ci][jj] = pv; l += pv;
    }
    l += SHX(l, 1); l += SHX(l, 2); l += SHX(l, 4); l += SHX(l, 8);
    mx[jj] = m; ls[jj] = l;
  }
  __syncthreads();
  _Pragma("unroll") for (int ci = 0; ci < 9; ++ci) _Pragma("unroll") for (int jj = 0; jj < 4; ++jj) Pl[(q * 4 + jj) * 168 + ci * 16 + c] = f2bf(S[ci][jj]);
  _Pragma("unroll") for (int jj = 0; jj < 4; ++jj) Pl[(q * 4 + jj) * 168 + 144 + c] = 0;
  asm volatile("s_waitcnt lgkmcnt(0)" ::: "memory");
  bf16x8 pf[5];
  _Pragma("unroll") for (int kk = 0; kk < 5; ++kk) pf[kk] = *(const bf16x8*)(Pl + c * 168 + kk * 32 + q * 8);
  asm volatile("s_waitcnt lgkmcnt(0)" ::: "memory");
  float il[4];
  _Pragma("unroll") for (int jj = 0; jj < 4; ++jj) il[jj] = frcp(ls[jj]);
  bfu* Ow = Pl;
  _Pragma("unroll") for (int dt = 0; dt < 8; ++dt) {
    f32x4 a = (f32x4){0.f, 0.f, 0.f, 0.f};
    _Pragma("unroll") for (int kk = 0; kk < 5; ++kk) {
      const int k0_ = w * 16 + kk * 32 + q * 8; const int ch_ = k0_ >> 3;
      const int chp_ = (ch_ < 32) ? (ch_ ^ (((dt * 16 + c) >> 3) & 15)) : ch_;
      bf16x8 vf = *(const bf16x8*)(Vt + (dt * 16 + c) * 280 + chp_ * 8);
      a = __builtin_amdgcn_mfma_f32_16x16x32_bf16(pf[kk], vf, a, 0, 0, 0);
    }
    _Pragma("unroll") for (int jj = 0; jj < 4; ++jj) Ow[(q * 4 + jj) * 136 + dt * 16 + c] = f2bf(a[jj] * il[jj]);
  }
  asm volatile("s_waitcnt lgkmcnt(0)" ::: "memory");
  _Pragma("unroll") for (int i = 0; i < 4; ++i) {
    const int id = lane + 64 * i; const int rr = id >> 4, c8 = id & 15;
    long orow = rowb + (long)(qb * 128 + w * 16 + rr) * dil + r;
    *(bf16x8*)(buf + orow * 4608 + qcol + c8 * 8) = *(const bf16x8*)(Ow + rr * 136 + c8 * 8);
  }
  if (c == 0) {
    _Pragma("unroll") for (int jj = 0; jj < 4; ++jj) {
      long orow = rowb + (long)(qb * 128 + w * 16 + q * 4 + jj) * dil + r;
      misc[MF_LSE + ((long)pat * MTOK + orow) * 4 + head] = mx[jj] + flog(ls[jj]);
    }
  }
}

__device__ void hg_pre_item(const Params& p, int L, int idx) {
  const int li = L >> 1;
  float* misc = (float*)(p.ws + MISC_OFF);
  bfu* buf = (bfu*)(p.ws + R_OFF);
  const int b = idx >> 8, h = (idx >> 6) & 3, n = idx & 63;
  const long R0 = (long)b * TSEQ + n * 64;
  int zoff = 0; asm volatile("" : "+v"(zoff));
  unsigned char* sb = smem + zoff;
  float* bs = (float*)sb;
  bfu* qb = (bfu*)(sb + 33792);
  bfu* kb = (bfu*)(sb + 51200);
  bfu* vT = (bfu*)(sb + 68608);
  bfu* qt = (bfu*)(sb + 87040);
  bfu* kt = (bfu*)(sb + 104448);
  bfu* at = (bfu*)(sb + 130560);
  int tid = ptid_(p.tid); asm volatile("" : "+v"(tid));
  const int wid = tid >> 6, lane = tid & 63, c16 = lane & 15, q4 = lane >> 4;
  const float LOG2E = 1.4426950408889634f;
  __syncthreads();
  for (int e = tid; e < 64 * 72 / 2; e += NTHR) ((unsigned*)at)[e] = 0u;
  { const int d = tid & 127, rg = tid >> 7;
    const float lb = misc[MF_LB + li * 512 + h * 128 + d];
    bfu hqv[16], hfv[16], hiv[16];
    _Pragma("unroll") for (int i = 0; i < 16; ++i) {
      const bfu* pr = buf + (R0 + rg * 16 + i) * 4608 + 1536 + h * 128 + d;
      hqv[i] = pr[0]; hfv[i] = pr[512]; hiv[i] = pr[1024];
    }
    _Pragma("unroll") for (int i = 0; i < 16; ++i) {
      const int r = rg * 16 + i;
      float hq = bf2f(hqv[i]), hf = bf2f(hfv[i]);
      float sg = sigmoidf_(hf);
      float f = lb + (1.0f - lb) * sg;
      qb[r * 136 + d] = f2bf(siluf_(hq));
      kb[r * 136 + d] = f2bf((1.0f - lb) * sigmoidf_(-hf));
      bs[r * 132 + d] = __builtin_amdgcn_logf(f);
      vT[d * 72 + r] = hiv[i];
    }
  }
  __syncthreads();
  if (tid < 128) { float a = 0.f; for (int r = 0; r < 64; ++r) { a += bs[r * 132 + tid]; bs[r * 132 + tid] = a; } }
  __syncthreads();
  { const int d = tid & 127, rg = tid >> 7;
    const float rown = (rg == 0) ? 0.f : bs[(16 * rg - 1) * 132 + d];
    const float r1 = bs[15 * 132 + d], r2 = bs[31 * 132 + d], r3 = bs[47 * 132 + d];
    for (int r = rg * 16; r < rg * 16 + 16; ++r) {
      const float bb = bs[r * 132 + d];
      const float qv = bf2f(qb[r * 136 + d]), kv = bf2f(kb[r * 136 + d]);
      qt[r * 136 + d] = f2bf(qv * __builtin_amdgcn_exp2f(bb - rown));
      { const int Lq = fragA_128(r, d); buf[(R0 + (Lq >> 7)) * 4608 + 1536 + h * 128 + (Lq & 127)] = f2bf(qv * __builtin_amdgcn_exp2f(bb)); }
      if (rg < 1) kt[(0 + r) * 136 + d] = f2bf(kv * __builtin_amdgcn_exp2f(r1 - bb));
      if (rg < 2) kt[(16 + r) * 136 + d] = f2bf(kv * __builtin_amdgcn_exp2f(r2 - bb));
      if (rg < 3) kt[(48 + r) * 136 + d] = f2bf(kv * __builtin_amdgcn_exp2f(r3 - bb));
    }
    if (tid < 128) misc[MF_EB + (long)idx * 128 + tid] = __builtin_amdgcn_exp2f(bs[63 * 132 + tid]);
  }
  { const int s = tid & 63, dg = tid >> 6;
    for (int d = dg * 16; d < dg * 16 + 16; ++d) {
      float kd = bf2f(kb[s * 136 + d]) * __builtin_amdgcn_exp2f(bs[63 * 132 + d] - bs[s * 132 + d]);
      { const int Lk = fragA_64(d, s); buf[(R0 + (Lk >> 7)) * 4608 + 2048 + h * 128 + (Lk & 127)] = f2bf(kd); }
    }
  }
  for (int ch = tid; ch < 1024; ch += NTHR) {
    const int e = ch >> 3, c8 = ch & 7;
    { const int Lv = fragA_64(e, c8 * 8); *(u32x4*)(buf + (R0 + (Lv >> 7)) * 4608 + 2560 + h * 128 + (Lv & 127)) = *(const u32x4*)(vT + e * 72 + c8 * 8); }
  }
  for (int rd = 0; rd < 9; ++rd) {
    const int pi = (rd * NTHR + tid) >> 3, part = tid & 7;
    const bool act = pi < 544;
    const int pj = act ? pi : 0;
    const int blk = pj / 136, tri = pj - blk * 136;
    int t = (int)((__builtin_amdgcn_sqrtf((float)(8 * tri + 1)) - 1.0f) * 0.5f);
    if ((t + 1) * (t + 2) / 2 <= tri) ++t;
    if (t * (t + 1) / 2 > tri) --t;
    const int s = tri - t * (t + 1) / 2;
    const int T = blk * 16 + t, S = blk * 16 + s;
    float acc = 0.f;
    _Pragma("unroll") for (int e = 0; e < 16; ++e) {
      const int d = part * 16 + e;
      acc += bf2f(qb[T * 136 + d]) * bf2f(kb[S * 136 + d]) * __builtin_amdgcn_exp2f(bs[T * 132 + d] - bs[S * 132 + d]);
    }
    acc += SHX(acc, 1); acc += SHX(acc, 2); acc += SHX(acc, 4);
    if (part == 0 && act) at[T * 72 + S] = f2bf(acc);
  }
  __syncthreads();
  if (wid < 6) {
    const int i = (wid < 1) ? 1 : (wid < 3 ? 2 : 3);
    const int j = (wid < 1) ? 0 : (wid < 3 ? (wid - 1) : (wid - 3));
    const int kbase = (i == 1) ? 0 : (i == 2 ? 16 : 48);
    f32x4 a = (f32x4){0.f, 0.f, 0.f, 0.f};
    _Pragma("unroll") for (int kk = 0; kk < 4; ++kk) {
      bf16x8 af = *(const bf16x8*)(qt + (i * 16 + c16) * 136 + kk * 32 + q4 * 8);
      bf16x8 bf = *(const bf16x8*)(kt + (kbase + j * 16 + c16) * 136 + kk * 32 + q4 * 8);
      a = __builtin_amdgcn_mfma_f32_16x16x32_bf16(af, bf, a, 0, 0, 0);
    }
    _Pragma("unroll") for (int jj = 0; jj < 4; ++jj) at[(i * 16 + q4 * 4 + jj) * 72 + j * 16 + c16] = f2bf(a[jj]);
  }
  __syncthreads();
  { bf16x8 bv[2];
    _Pragma("unroll") for (int k2 = 0; k2 < 2; ++k2) bv[k2] = *(const bf16x8*)(vT + (wid * 16 + c16) * 72 + k2 * 32 + q4 * 8);
    _Pragma("unroll") for (int rt = 0; rt < 4; ++rt) {
      f32x4 a = (f32x4){0.f, 0.f, 0.f, 0.f};
      _Pragma("unroll") for (int k2 = 0; k2 < 2; ++k2) {
        bf16x8 af = *(const bf16x8*)(at + (rt * 16 + c16) * 72 + k2 * 32 + q4 * 8);
        a = __builtin_amdgcn_mfma_f32_16x16x32_bf16(af, bv[k2], a, 0, 0, 0);
      }
      _Pragma("unroll") for (int jj = 0; jj < 4; ++jj)
        buf[(R0 + rt * 16 + q4 * 4 + jj) * 4608 + 3584 + h * 128 + wid * 16 + c16] = f2bf(a[jj]);
    }
  }
}

__device__ void hg_scan_block(const Params& p, int L, int item) {
  float* misc = (float*)(p.ws + MISC_OFF);
  bfu* buf = (bfu*)(p.ws + R_OFF);
  const int bh = item >> 2, qt = item & 3;
  int tid = ptid_(p.tid); asm volatile("" : "+v"(tid));
  const int w = tid >> 6, lane = tid & 63, c = lane & 15, q = lane >> 4;
  const int rt = w >> 1, ct = w & 1, dt = w;
  bfu* St = (bfu*)smem;
  const int b = bh >> 2, h = bh & 3;
  __syncthreads();
  for (int i = tid; i < 4 * 2176; i += NTHR) St[i] = 0;
  f32x4 Sacc[2];
  Sacc[0] = (f32x4){0.f, 0.f, 0.f, 0.f}; Sacc[1] = Sacc[0];
#define HG_DECL(X) bf16x8 qd##X[4], kd##X[2], vt##X[2][2]; float oi##X[4], eb##X[4];
  HG_DECL(A) HG_DECL(B) HG_DECL(C)
#define HG_LOAD(X, nn) do { const long R0 = (long)b * TSEQ + (nn) * 64; \
    const bfu* hb_ = buf + (R0 + (lane >> 4)) * 4608 + h * 128 + (lane & 15) * 8; \
    _Pragma("unroll") for (int kk = 0; kk < 4; ++kk) qd##X[kk] = *(const bf16x8*)(hb_ + (long)((rt * 4 + kk) * 4) * 4608 + 1536); \
    _Pragma("unroll") for (int k2 = 0; k2 < 2; ++k2) { \
      kd##X[k2] = *(const bf16x8*)(hb_ + (long)((dt * 2 + k2) * 4) * 4608 + 2048); \
      _Pragma("unroll") for (int cc = 0; cc < 2; ++cc) \
        vt##X[cc][k2] = *(const bf16x8*)(hb_ + (long)(((qt * 2 + cc) * 2 + k2) * 4) * 4608 + 2560); } \
    _Pragma("unroll") for (int j = 0; j < 4; ++j) { oi##X[j] = bf2f(buf[(R0 + rt * 16 + q * 4 + j) * 4608 + 3584 + h * 128 + qt * 32 + ct * 16 + c]); \
      eb##X[j] = misc[MF_EB + ((long)bh * 64 + (nn)) * 128 + dt * 16 + q * 4 + j]; } } while (0)
#define HG_STEP(X, n) do { \
    const bfu* Sc = St + ((n) & 1) * 4352; \
    bfu* Sn = St + (((n) + 1) & 1) * 4352; \
    f32x4 o; \
    _Pragma("unroll") for (int j = 0; j < 4; ++j) o[j] = oi##X[j]; \
    _Pragma("unroll") for (int kk = 0; kk < 4; ++kk) { \
      bf16x8 bS = *(const bf16x8*)(Sc + ct * 2176 + c * 136 + kk * 32 + q * 8); \
      o = __builtin_amdgcn_mfma_f32_16x16x32_bf16(qd##X[kk], bS, o, 0, 0, 0); } \
    _Pragma("unroll") for (int j = 0; j < 4; ++j) { \
      long row = (long)b * TSEQ + (n) * 64 + rt * 16 + q * 4 + j; \
      buf[row * 4608 + 3584 + h * 128 + qt * 32 + ct * 16 + c] = f2bf(o[j]); } \
    _Pragma("unroll") for (int cc = 0; cc < 2; ++cc) { \
      f32x4 a; \
      _Pragma("unroll") for (int j = 0; j < 4; ++j) a[j] = Sacc[cc][j] * eb##X[j]; \
      _Pragma("unroll") for (int k2 = 0; k2 < 2; ++k2) a = __builtin_amdgcn_mfma_f32_16x16x32_bf16(kd##X[k2], vt##X[cc][k2], a, 0, 0, 0); \
      Sacc[cc] = a; \
      uint2 so; so.x = pack2(a[0], a[1]); so.y = pack2(a[2], a[3]); \
      *(uint2*)(Sn + cc * 2176 + c * 136 + dt * 16 + q * 4) = so; } \
    LBAR; } while (0)
  HG_LOAD(A, 0); HG_LOAD(B, 1);
  __syncthreads();
  for (int n = 0; n < 63; n += 3) {
    HG_LOAD(C, n + 2); HG_STEP(A, n);
    HG_LOAD(A, n + 3); HG_STEP(B, n + 1);
    if (n + 4 < 64) HG_LOAD(B, n + 4);
    HG_STEP(C, n + 2);
  }
  HG_STEP(A, 63);
}

__device__ void cd_fin_rows(const Params& p, int L, int row0, int nrows, const bool doC, const bool doD) {
  const int li = L >> 1;
  const float* misc = (const float*)(p.ws + MISC_OFF);
  bfu* buf = (bfu*)(p.ws + R_OFF);
  int tid = ptid_(p.tid); asm volatile("" : "+v"(tid)); const int wid = tid >> 6, lane = tid & 63;
  for (int rr = wid; rr < nrows; rr += 8) {
    const long row = row0 + rr;
    bfu* pr = buf + row * 4608;
    const int c0 = lane * 8;
    if (doC) {
    bf16x8 o = *(const bf16x8*)(pr + 3584 + c0);
    bf16x8 hg = *(const bf16x8*)(pr + 1536 + 1536 + c0);
    float of[8]; float ss = 0.f;
    for (int e = 0; e < 8; ++e) { of[e] = bf2f((bfu)o[e]); ss += of[e] * of[e]; }
    ss += SHX(ss, 1); ss += SHX(ss, 2); ss += SHX(ss, 4); ss += SHX(ss, 8);
    const float rs = frsq(ss * (1.0f / 128.0f) + 1e-6f);
    float ra[8];
    for (int e = 0; e < 8; ++e) ra[e] = of[e] * rs * p.hg_norm_g[li * 128 + ((c0 + e) & 127)] * sigmoidf_(bf2f((bfu)hg[e]));
    uint4 wa; wa.x = pack2(ra[0], ra[1]); wa.y = pack2(ra[2], ra[3]); wa.z = pack2(ra[4], ra[5]); wa.w = pack2(ra[6], ra[7]);
    *(uint4*)(pr + 1536 + c0) = wa;
    }
    if (doD) {
    const int head = lane >> 4;
    float l0 = misc[MF_LSE + ((long)0 * MTOK + row) * 4 + head];
    float l1 = misc[MF_LSE + ((long)1 * MTOK + row) * 4 + head];
    float l2 = misc[MF_LSE + ((long)2 * MTOK + row) * 4 + head];
    float mm = fmaxf(l0, fmaxf(l1, l2));
    float e0 = fexp(l0 - mm), e1 = fexp(l1 - mm), e2 = fexp(l2 - mm);
    float inv = frcp(e0 + e1 + e2);
    e0 *= inv; e1 *= inv; e2 *= inv;
    bf16x8 o0 = *(const bf16x8*)(pr + c0), o1 = *(const bf16x8*)(pr + 512 + c0), o2 = *(const bf16x8*)(pr + 1024 + c0);
    float rd[8];
    for (int e = 0; e < 8; ++e) rd[e] = e0 * bf2f((bfu)o0[e]) + e1 * bf2f((bfu)o1[e]) + e2 * bf2f((bfu)o2[e]);
    uint4 wb; wb.x = pack2(rd[0], rd[1]); wb.y = pack2(rd[2], rd[3]); wb.z = pack2(rd[4], rd[5]); wb.w = pack2(rd[6], rd[7]);
    *(uint4*)(pr + c0) = wb;
    }
  }
}


#define XB_TMO      128
#define XB_XCNT(j)  (256  + 64 * (j))
#define XB_XSUB(j)  (1280 + 64 * (j))
#define XB_XGEN(j)  (2304 + 64 * (j))
#define XB_TOP      3328
#define XB_TOPGEN   3392
#define XCD_BAR_WORDS 3456
#define XB_SPIN_CAP (1u << 18)
#define LAS __attribute__((address_space(3)))
__device__ __forceinline__ unsigned xb_ld(unsigned* p)              { return __hip_atomic_load(p, __ATOMIC_RELAXED, __HIP_MEMORY_SCOPE_AGENT); }
__device__ __forceinline__ unsigned xb_add(unsigned* p, unsigned v) { return __hip_atomic_fetch_add(p, v, __ATOMIC_RELAXED, __HIP_MEMORY_SCOPE_AGENT); }
__device__ __forceinline__ unsigned xb_xcc_id() { return (unsigned)__builtin_amdgcn_s_getreg((3 << 11) | 20) & 0xFu; }
#define XB_SPIN(cond, bar) do { unsigned _sp = 0; while (cond) { __builtin_amdgcn_s_sleep(1); \
    if ((++_sp & 255u) == 0u) { if (xb_ld(&(bar)[XB_TMO])) break; if (_sp > XB_SPIN_CAP) { atomicAdd(&(bar)[XB_TMO], 1u); break; } } } } while (0)
struct XcdBarrier { unsigned* bar; unsigned x; volatile LAS unsigned* st; };
__device__ __forceinline__ XcdBarrier xcd_barrier_post(unsigned* bar, volatile LAS unsigned* st) {
  XcdBarrier b; b.bar = bar; b.x = xb_xcc_id(); b.st = st;
  if (threadIdx.x == 0) (void)xb_add(&bar[XB_XCNT(b.x)], 1u);
  return b;
}
__device__ __forceinline__ void xcd_barrier_complete(unsigned* bar, unsigned x, unsigned& nloc, unsigned& nx) {
  const unsigned G = gridDim.x * gridDim.y * gridDim.z;
  unsigned sum, cnt, mine, sp = 0u;
  for (;;) {
    sum = 0u; cnt = 0u; mine = 0u;
#pragma unroll
    for (unsigned j = 0; j < 16; ++j) { const unsigned c = xb_ld(&bar[XB_XCNT(j)]); sum += c; cnt += (c > 0u) ? 1u : 0u; mine = (j == x) ? c : mine; }
    if (sum == G) break;
    __builtin_amdgcn_s_sleep(1);
    if ((++sp & 255u) == 0u) { if (xb_ld(&bar[XB_TMO])) break; if (sp > XB_SPIN_CAP) { atomicAdd(&bar[XB_TMO], 1u); break; } }
  }
  nloc = mine > 0u ? mine : 1u; nx = cnt > 0u ? cnt : 1u;
}
__device__ __forceinline__ void xcd_barrier(const XcdBarrier& b) {
  asm volatile("s_waitcnt vmcnt(0)" ::: "memory");
  __syncthreads();
  if (threadIdx.x == 0) {
    unsigned* bar = b.bar;
    __builtin_amdgcn_s_waitcnt(0);
    unsigned nloc = b.st[0], nx = b.st[1];
    if (nloc == 0u) { xcd_barrier_complete(bar, b.x, nloc, nx); b.st[0] = nloc; b.st[1] = nx; }
    const unsigned old = xb_add(&bar[XB_XSUB(b.x)], 1u);
    const unsigned gen = old / nloc;
    if (old + 1u == (gen + 1u) * nloc) {
      __builtin_amdgcn_fence(__ATOMIC_RELEASE, "agent");
      asm volatile("s_waitcnt vmcnt(0)" ::: "memory");
      const unsigned og = xb_add(&bar[XB_TOP], 1u);
      const unsigned tg = og / nx;
      if (og + 1u == (tg + 1u) * nx) xb_add(&bar[XB_TOPGEN], 1u);
      else XB_SPIN(xb_ld(&bar[XB_TOPGEN]) == tg, bar);
      __builtin_amdgcn_fence(__ATOMIC_ACQUIRE, "agent");
      xb_add(&bar[XB_XGEN(b.x)], 1u);
      asm volatile("s_waitcnt vmcnt(0)" ::: "memory");
    } else {
      XB_SPIN(xb_ld(&bar[XB_XGEN(b.x)]) == gen, bar);
      __builtin_amdgcn_fence(__ATOMIC_ACQUIRE, "agent");
      asm volatile("s_waitcnt vmcnt(0)" ::: "memory");
    }
  }
  __syncthreads();
}

__global__ void __launch_bounds__(NTHR, 2) fwd_megakernel(Params p) {
  cg::grid_group grid = cg::this_grid();
  const int G = gridDim.x;
  const int wave_id_ = __builtin_amdgcn_readfirstlane((int)(threadIdx.x >> 6));
  volatile LAS unsigned* xb_st = (volatile LAS unsigned*)(smem + 163824);
  if (threadIdx.x == 0) { xb_st[0] = 0u; xb_st[1] = 0u; xb_st[2] = 0u; xb_st[3] = 0u; }
  __syncthreads();
  XcdBarrier xb = xcd_barrier_post((unsigned*)(p.ws + BAR_BYTE_OFF), xb_st);
  for (int ph = p.phase_lo; ph < p.phase_hi; ++ph) {
    int L = 0, kind = 0;
    if (ph == 0) kind = 0;
    else if (ph >= 33) kind = 14;
    else {
      int r = ph - 1;
      if (r < 7) { L = 0; } else if (r < 16) { L = 1; r -= 7; } else if (r < 23) { L = 2; r -= 16; } else { L = 3; r -= 23; }
      if ((L & 1) == 0) kind = 1 + r;
      else kind = (r < 6) ? (8 + r) : (5 + (r - 6));
    }
    const long wb = wt_base(L);
    const bool even = (L & 1) == 0;
    const long w_out = wb + (even ? 3584L : 6656L) * 1024, w_gu = wb + (even ? 4608L : 7680L) * 1024, w_dn = wb + (even ? 10240L : 13312L) * 1024;
#ifndef REPEAT_MASK
#define REPEAT_MASK 0
#endif
#ifndef REPEAT_N
#define REPEAT_N 1
#endif
    const int nrep = ((REPEAT_MASK >> kind) & 1) ? REPEAT_N : 1;
    for (int rep = 0; rep < nrep; ++rep) {
    if (rep > 0) xcd_barrier(xb);
    { p.tid = wave_id_;
      int b_ = blockIdx.x; asm volatile("" : "+s"(b_)); p.bid = b_;
      }
    float* misc = (float*)(p.ws + MISC_OFF);
    const bfu* wt = (const bfu*)(p.ws + WT_OFF);
    bfu* hb = (bfu*)(p.ws + HB_OFF);
    float* rs_mix = misc + MF_RSP + (L == 0 ? 0L : 2L * MTOK * 16);
    float* rs_ffn = misc + MF_RSP + 1L * MTOK * 16;
    float* rs_next = misc + MF_RSP + 2L * MTOK * 16;
    bfu* pab = (bfu*)(p.ws + PAB_OFF);
    bfu* buf = (bfu*)(p.ws + R_OFF);
    switch (kind) {
      case 0: phase_prologue(p); break;
      case 1: case 10: {
        GemmArgs g{}; g.tid = p.tid; g.A = hb; g.lda = 1024; g.asplit = 1 << 30; g.K = 1024; g.rowss = rs_mix;
        if (kind == 1) { g.Bt = wt + wb; g.outb = pab; g.ldo = 3584; g.ocol0 = 0; gemm_phase<EPI_PLAIN>(g, 128, 14, 256, p, L); }
        else { g.Bt = wt + wb + 4608L * 1024; g.outb = buf; g.ldo = 4608; g.ocol0 = 1536; gemm_phase<EPI_PLAIN>(g, 128, 8, 0, p, L); }
      } break;
      case 2: for (int it = p.bid; it < 2048; it += G) dn_pre_item(p, L, it); break;
      case 3: case 12: {
        const bool big = G >= 256;
        const int VG = big ? G - 128 : G, vb = big ? p.bid - 128 : p.bid;
        if (!big || p.bid < 128) {
          for (int it = p.bid; it < 128; it += (big ? 128 : G)) {
            const int item = (it & 7) * 16 + (it >> 3);
            if (kind == 3) dn_scan_block(p, L, item); else hg_scan_block(p, L, item);
          }
        }
        if ((!big || p.bid >= 128) && rep == 0) {
          const int cL0 = L, cj0 = (L & 1) ? 2 : 1, cL1 = (L < 3) ? L + 1 : 3, cj1 = (L == 3) ? 4 : ((L & 1) ? 0 : 1);
          cvt_jobs(p, cL0, cj0, cL1, cj1, vb, VG);
        }
        if ((!big || p.bid >= 128) && rep == nrep - 1) {
          for (int it = vb; it < 256; it += VG) {
            if (kind == 3) ab_fin_rows(p, L, it * 128, 128, false, true); else cd_fin_rows(p, L, it * 128, 128, false, true);
          }
        }
      } break;
      case 4: for (int it = p.bid; it < 256; it += G) ab_fin_rows(p, L, it * 128, 128, true, false); break;
      case 5: case 7: {
        GemmArgs g{}; g.tid = p.tid; g.asplit = 1 << 30; g.hout = p.out; g.hb = hb; g.hres = p.x; g.res_bf16 = (kind == 5 && L == 0) ? 0 : 1;
        if (kind == 5) {
          g.K = 1024; g.Bt = wt + w_out; g.rowss_next = rs_ffn;
          if (even) { g.A = pab; g.lda = 3584; g.aoff0 = 512; }
          else { g.A = buf; g.lda = 4608; g.aoff0 = 1536; g.aoff1 = 0; g.asplit = 512; }
        } else { g.A = buf; g.lda = 2816; g.K = 2816; g.Bt = wt + w_dn; g.rowss_next = rs_next; }
        gemm_phase<EPI_RES>(g, 128, 4, 0, p, L);
      } break;
      case 6: {
        GemmArgs g{}; g.tid = p.tid; g.A = hb; g.lda = 1024; g.asplit = 1 << 30; g.Bt = wt + w_gu; g.K = 1024;
        g.rowss = rs_ffn; g.outb = buf; g.ldo = 2816; g.ocol0 = 0;
        gemm_phase<EPI_GLU>(g, 128, 22, 0, p, L);
      } break;
      case 8: {
        GemmArgs g{}; g.tid = p.tid; g.A = hb; g.lda = 1024; g.asplit = 1 << 30; g.Bt = wt + wb; g.K = 1024;
        g.rowss = rs_mix; g.outb = buf; g.ldo = 4608; g.ocol0 = 0; g.rope = misc + MF_ROPE;
        gemm_phase<EPI_SWA>(g, 128, 18, 0, p, L);
      } break;
      case 9: for (int it = remap_block(p.bid, G); it < 3072; it += G) swa_item(p, it); break;
      case 11: for (int it = p.bid; it < 2048; it += G) hg_pre_item(p, L, it); break;
      case 13: for (int it = p.bid; it < 256; it += G) cd_fin_rows(p, L, it * 128, 128, true, false); break;
      default: {
        const float* rsf = misc + MF_RSP + 2L * MTOK * 16;
        const int tid_f = ptid_(p.tid); const int wid = tid_f >> 6, lane = tid_f & 63;
        for (int row = p.bid * 8 + wid; row < MTOK; row += G * 8) {
          float s16 = 0.f; for (int i = 0; i < 16; ++i) s16 += rsf[(long)row * 16 + i];
          float rs = frsq(s16 * (1.0f / 1024.0f) + 1e-6f);
          float* pr = p.out + (long)row * 1024;
          const bfu* hr = hb + (long)row * 1024;
          for (int i = 0; i < 2; ++i) {
            int c = i * 512 + lane * 8;
            bf16x8 hv = *(const bf16x8*)(hr + c);
            float4 g0 = *(const float4*)(p.norm_final_g + c), g1 = *(const float4*)(p.norm_final_g + c + 4);
            float4 o0, o1;
            o0.x = bf2f((bfu)hv[0]) * rs * g0.x; o0.y = bf2f((bfu)hv[1]) * rs * g0.y; o0.z = bf2f((bfu)hv[2]) * rs * g0.z; o0.w = bf2f((bfu)hv[3]) * rs * g0.w;
            o1.x = bf2f((bfu)hv[4]) * rs * g1.x; o1.y = bf2f((bfu)hv[5]) * rs * g1.y; o1.z = bf2f((bfu)hv[6]) * rs * g1.z; o1.w = bf2f((bfu)hv[7]) * rs * g1.w;
            *(float4*)(pr + c) = o0; *(float4*)(pr + c + 4) = o1;
          }
        }
      } break;
    }
    }
    if (ph + 1 < p.phase_hi) { if (ph == p.phase_lo) grid.sync(); else xcd_barrier(xb); }
  }
}

extern "C" void kernel_launch(void* const* d_in, const int* in_sizes, int n_in, void* d_out, int out_size,
                              void* d_ws, size_t ws_size, hipStream_t stream) {
  constexpr size_t kDynLds = 160 * 1024;
  static int grid_blocks = 0;
  if (!grid_blocks) {
    int dev = 0, cus = 0, per_cu = 0;
    (void)hipGetDevice(&dev);
    (void)hipDeviceGetAttribute(&cus, hipDeviceAttributeMultiprocessorCount, dev);
    (void)hipFuncSetAttribute((const void*)fwd_megakernel, hipFuncAttributeMaxDynamicSharedMemorySize, (int)kDynLds);
    (void)hipOccupancyMaxActiveBlocksPerMultiprocessor(&per_cu, fwd_megakernel, NTHR, kDynLds);
    if (per_cu < 1) per_cu = 1;
    grid_blocks = cus * per_cu;
  }
  Params p{};
  const float** f = (const float**)&p;
  for (int i = 0; i < 18; ++i) f[i] = (const float*)d_in[i];
  p.out = (float*)d_out; p.ws = (char*)d_ws;
  p.phase_lo = 0; p.phase_hi = 34;
  (void)hipMemsetAsync((char*)d_ws + BAR_BYTE_OFF, 0, XCD_BAR_WORDS * sizeof(unsigned), stream);
  void* args[] = {&p};
  hipError_t e = hipLaunchCooperativeKernel((void*)fwd_megakernel, dim3(grid_blocks), dim3(NTHR), args, kDynLds, stream);
  if (e != hipSuccess) fprintf(stderr, "cooperative launch failed: %s (grid %d)\n", hipGetErrorString(e), grid_blocks);
}
```

```cpp
#include <hip/hip_runtime.h>
#include <hip/hip_bf16.h>
#include <hip/hip_cooperative_groups.h>
#include <cstdio>
namespace cg = cooperative_groups;

typedef unsigned short bfu;
using bf16x8 = __attribute__((ext_vector_type(8))) short;
using f32x4 = __attribute__((ext_vector_type(4))) float;
using u32x4 = __attribute__((ext_vector_type(4))) unsigned;
using u32x2 = __attribute__((ext_vector_type(2))) unsigned;
#define LBAR do { asm volatile("s_waitcnt lgkmcnt(0)" ::: "memory"); __builtin_amdgcn_s_barrier(); asm volatile("" ::: "memory"); } while (0)
#define GPTR(T, ptr) ((__attribute__((address_space(1))) T*)(ptr))

#define MTOK 32768
#define TSEQ 4096
#define NTHR 512

#define WT_OFF 0L
#define MISC_OFF (114L << 20)
#define HB_OFF (130L << 20)
#define R_OFF (194L << 20)
#define PAB_OFF (R_OFF + (80L << 20))
#define DNP_OFF HB_OFF
#define MF_ROWSS 0
#define MF_LB 294912
#define MF_WBA 295936
#define MF_BG 312320
#define MF_GTOT 574464
#define MF_EB 576512
#define MF_LSE 838656
#define MF_ROPE 1231872
#define MF_RSP 1760000
#define BAR_BYTE_OFF (MISC_OFF + (15L << 20))

struct Params {
  const float* x; const float* norm_mix_g; const float* norm_ffn_g; const float* norm_final_g;
  const float* ab_w_in; const float* dn_conv_w; const float* dn_a_log; const float* dn_dt_bias;
  const float* dn_norm_g; const float* sc_conv_w; const float* ab_w_out; const float* cd_w_in;
  const float* hg_lb; const float* hg_norm_g; const float* cd_w_out;
  const float* ffn_w_gate; const float* ffn_w_up; const float* ffn_w_down;
  float* out; char* ws;
  int phase_lo, phase_hi;
  int tid, bid;
};

extern __shared__ __attribute__((aligned(16))) unsigned char smem[];

__device__ __forceinline__ bfu f2bf(float f) {
  unsigned u = __float_as_uint(f);
  u += 0x7fffu + ((u >> 16) & 1u);
  return (bfu)(u >> 16);
}
__device__ __forceinline__ float bf2f(bfu h) { return __uint_as_float(((unsigned)h) << 16); }
__device__ __forceinline__ unsigned pack2(float a, float b) { return (unsigned)f2bf(a) | ((unsigned)f2bf(b) << 16); }
__device__ __forceinline__ float fexp(float x) { return __builtin_amdgcn_exp2f(x * 1.4426950408889634f); }
__device__ __forceinline__ float flog(float x) { return __builtin_amdgcn_logf(x) * 0.6931471805599453f; }
__device__ __forceinline__ float frsq(float x) { return __builtin_amdgcn_rsqf(x); }
__device__ __forceinline__ float frcp(float x) { return __builtin_amdgcn_rcpf(x); }
__device__ __forceinline__ float sigmoidf_(float x) { return frcp(1.0f + fexp(-x)); }
__device__ __forceinline__ float siluf_(float x) { return x * frcp(1.0f + fexp(-x)); }

__device__ __forceinline__ float shx_(float v, int m, int lane) { return __builtin_bit_cast(float, __builtin_amdgcn_ds_bpermute((lane ^ m) << 2, __builtin_bit_cast(int, v))); }
__device__ __forceinline__ float shup_(float v, int o, int lane) { return __builtin_bit_cast(float, __builtin_amdgcn_ds_bpermute((lane - o) << 2, __builtin_bit_cast(int, v))); }
#define SHX(v, m) shx_((v), (m), lane)
__device__ __forceinline__ long wt_base(int L) { return ((long)(L >> 1) * 29184L + (long)(L & 1) * 13056L) * 1024L; }

__device__ __forceinline__ int ptid_(int wave) { int l_; asm volatile("v_mbcnt_lo_u32_b32 %0, -1, 0\n\tv_mbcnt_hi_u32_b32 %0, -1, %0" : "=v"(l_)); return (wave << 6) | l_; }
constexpr int BM = 256, BK = 64, HALF = 128, HT = HALF * BK;

__device__ __forceinline__ int lds_byte(int r, int c) {
  int st = (r >> 4) * 2 + (c >> 5), rr = r & 15, cc = c & 31, ob = rr * 64 + cc * 2;
  return st * 1024 + (ob ^ (((ob >> 9) & 1) << 5));
}
__device__ __forceinline__ void stage_rc(int b, int& R, int& C) {
  int st = b / 1024, sb = b % 1024, swz = sb ^ (((sb >> 9) & 1) << 5);
  R = (st >> 1) * 16 + swz / 64; C = (st & 1) * 32 + (swz % 64) / 2;
}

struct GemmArgs {
  const bfu* A; int lda; int aoff0, aoff1, asplit;
  const bfu* Bt; int K;
  const float* rowss;
  bfu* outb; int ldo; int ocol0;
  const float* hres; float* hout; bfu* hb; float* rowss_next;
  const float* rope;
  int tid;
  int res_bf16;
};

enum { EPI_PLAIN = 0, EPI_SWA = 1, EPI_RES = 2, EPI_GLU = 3 };

template <int EPI>
__device__ __forceinline__ void gemm_tile(const GemmArgs& g, int brow, int bcol, int parity, bool first, bool nvalid, int nbrow, int nbcol) {
  bfu* shm = (bfu*)smem;
  const bfu* A = g.A; const bfu* Bt = g.Bt; const int K = g.K; const int lda = g.lda;
#define SA(b, h) (shm + ((b) * 2 + (h)) * HT)
#define SB(b, h) (shm + (4 + (b) * 2 + (h)) * HT)
#define STAGE_A(P, br, kt) do { int _kc = (kt) * BK; int _ac = (_kc < g.asplit) ? (g.aoff0 + _kc) : (g.aoff1 + _kc - g.asplit); \
    const char* _gb = (const char*)(A + ((long)(br) * lda + _ac)); \
    __builtin_amdgcn_global_load_lds((const unsigned*)(_gb + aofl0), (unsigned*)((char*)(P) + gtid_ * 16), 16, 0, 0); \
    __builtin_amdgcn_global_load_lds((const unsigned*)(_gb + (long)lda * 128 + aofl0), (unsigned*)((char*)(P) + gtid_ * 16 + 8192), 16, 0, 0); } while (0)
#define STAGE_B(P, br, kt) do { const char* _gb = (const char*)(Bt + ((long)(br) * K + (long)(kt) * BK)); \
    __builtin_amdgcn_global_load_lds((const unsigned*)(_gb + bofl0), (unsigned*)((char*)(P) + gtid_ * 16), 16, 0, 0); \
    __builtin_amdgcn_global_load_lds((const unsigned*)(_gb + (long)K * 128 + bofl0), (unsigned*)((char*)(P) + gtid_ * 16 + 8192), 16, 0, 0); } while (0)
#define LDA(dst, b, h) for (int m = 0; m < 4; ++m) for (int k = 0; k < 2; ++k) \
    dst[m][k] = *reinterpret_cast<const bf16x8*>((char*)SA(b, h) + lds_byte(wr * 64 + m * 16 + fr, k * 32 + fq * 8))
#define LDB(dst, b, h) for (int n = 0; n < 2; ++n) for (int k = 0; k < 2; ++k) \
    dst[n][k] = *reinterpret_cast<const bf16x8*>((char*)SB(b, h) + lds_byte(wc * 32 + n * 16 + fr, k * 32 + fq * 8))
#define MMA(ai, bj, At_, Bt_) do { __builtin_amdgcn_s_setprio(1); \
    for (int m = 0; m < 4; ++m) for (int n = 0; n < 2; ++n) for (int k = 0; k < 2; ++k) \
      acc[ai][bj][m][n] = __builtin_amdgcn_mfma_f32_16x16x32_bf16(At_[m][k], Bt_[n][k], acc[ai][bj][m][n], 0, 0, 0); \
    __builtin_amdgcn_s_setprio(0); } while (0)
#define WAIT_V(n) asm volatile("s_waitcnt vmcnt(" #n ")" ::: "memory")
#define WAIT_L(n) asm volatile("s_waitcnt lgkmcnt(" #n ")" ::: "memory")
#define BAR __builtin_amdgcn_s_barrier()
#define SCHED __builtin_amdgcn_sched_barrier(0)

  int gtid_ = ptid_(g.tid);
  const int wid = gtid_ >> 6, lane = gtid_ & 63, wr = wid >> 2, wc = wid & 3, fr = lane & 15, fq = lane >> 4;
  unsigned aofl0, bofl0;
  { int _r, _c; stage_rc(gtid_ * 16, _r, _c); aofl0 = (unsigned)(_r * lda + _c) * 2u; bofl0 = (unsigned)(_r * K + _c) * 2u; }
  f32x4 acc[2][2][4][2] = {};
  bf16x8 At[4][2], B0[2][2], B1[2][2];
  const int nt = K / BK;
  float* rstd_s = (float*)(smem + 153600) + (parity & 1) * 256;
  if (first) {
    WAIT_V(0);
    __syncthreads();
    STAGE_B(SB(0, 0), bcol, 0); STAGE_A(SA(0, 0), brow, 0);
    STAGE_B(SB(0, 1), bcol + HALF, 0); STAGE_A(SA(0, 1), brow + HALF, 0);
  }
  f32x4 ra0, ra1, ra2, ra3;
  if constexpr (EPI != EPI_RES) {
    if (gtid_ < 256) {
      const __attribute__((address_space(1))) f32x4* pp = GPTR(const f32x4, g.rowss + (long)(brow + gtid_) * 16);
      ra0 = pp[0]; ra1 = pp[1]; ra2 = pp[2]; ra3 = pp[3];
    }
  }
  if (wr == 1) BAR;
  if (first) { WAIT_V(4); } else { WAIT_V(0); }
  BAR;
  if constexpr (EPI != EPI_RES) {
    if (gtid_ < 256) {
      float s = ((ra0[0] + ra0[1]) + (ra0[2] + ra0[3])) + ((ra1[0] + ra1[1]) + (ra1[2] + ra1[3])) + ((ra2[0] + ra2[1]) + (ra2[2] + ra2[3])) + ((ra3[0] + ra3[1]) + (ra3[2] + ra3[3]));
      rstd_s[gtid_] = frsq(s * (1.0f / 1024.0f) + 1e-6f);
    }
  }
  STAGE_B(SB(1, 0), bcol, 1); STAGE_A(SA(1, 0), brow, 1); STAGE_B(SB(1, 1), bcol + HALF, 1);
  WAIT_V(6); BAR;
  for (int t = 0; t < nt - 2; t += 2) {
    LDB(B0, 0, 0); SCHED; LDA(At, 0, 0); STAGE_A(SA(1, 1), brow + HALF, t + 1);
    WAIT_L(8); BAR; WAIT_L(0); MMA(0, 0, At, B0); BAR; SCHED;
    LDB(B1, 0, 1); STAGE_B(SB(0, 0), bcol, t + 2);
    BAR; WAIT_L(0); MMA(0, 1, At, B1); BAR; SCHED;
    LDA(At, 0, 1); STAGE_A(SA(0, 0), brow, t + 2);
    BAR; WAIT_L(0); MMA(1, 0, At, B0); BAR; SCHED;
    STAGE_B(SB(0, 1), bcol + HALF, t + 2);
    WAIT_V(6); BAR; MMA(1, 1, At, B1); BAR; SCHED;
    LDB(B0, 1, 0); SCHED; LDA(At, 1, 0); STAGE_A(SA(0, 1), brow + HALF, t + 2);
    WAIT_L(8); BAR; WAIT_L(0); MMA(0, 0, At, B0); BAR; SCHED;
    LDB(B1, 1, 1); STAGE_B(SB(1, 0), bcol, t + 3);
    BAR; WAIT_L(0); MMA(0, 1, At, B1); BAR; SCHED;
    LDA(At, 1, 1); STAGE_A(SA(1, 0), brow, t + 3);
    BAR; WAIT_L(0); MMA(1, 0, At, B0); BAR; SCHED;
    STAGE_B(SB(1, 1), bcol + HALF, t + 3);
    WAIT_V(6); BAR; MMA(1, 1, At, B1); BAR; SCHED;
  }
  { LDB(B0, 0, 0); LDA(At, 0, 0); STAGE_A(SA(1, 1), brow + HALF, nt - 1);
    BAR; WAIT_L(0); MMA(0, 0, At, B0); BAR;
    LDB(B1, 0, 1); BAR; WAIT_L(0); MMA(0, 1, At, B1); BAR; SCHED;
    LDA(At, 0, 1); WAIT_V(4); BAR; WAIT_L(0); MMA(1, 0, At, B0); MMA(1, 1, At, B1); BAR; }
  { LDB(B0, 1, 0); LDA(At, 1, 0); WAIT_V(2); BAR; WAIT_L(0); MMA(0, 0, At, B0); BAR;
    LDB(B1, 1, 1); WAIT_V(0); BAR; WAIT_L(0); MMA(0, 1, At, B1); BAR; SCHED;
    LDA(At, 1, 1); BAR; WAIT_L(0); MMA(1, 0, At, B0); MMA(1, 1, At, B1); BAR; }
  if (wr == 0) BAR;
  if (nvalid) {
    STAGE_B(SB(0, 0), nbcol, 0); STAGE_A(SA(0, 0), nbrow, 0);
    STAGE_B(SB(0, 1), nbcol + HALF, 0); STAGE_A(SA(0, 1), nbrow + HALF, 0);
  }

  int rowb_ = brow + wr * 64 + fq * 4; asm volatile("" : "+v"(rowb_));
  int colb_ = bcol + wc * 32 + fr; asm volatile("" : "+v"(colb_));
  float* W = (float*)(smem + ((wid < 3) ? (32768 + wid * 9216) : (98304 + (wid - 3) * 9216)));
  const int wrow0 = rowb_ - fq * 4;
  const int wcol0 = colb_ - fr;
  const int lrow0 = wrow0 - brow;
#define W_WRITE(m, n, j, v) W[((m) * 16 + fq * 4 + (j)) * 36 + (n) * 16 + fr] = (v)
#define W_STORE_BF16(dstbase, ld) do { _Pragma("unroll") for (int ps = 0; ps < 4; ++ps) { \
      const int r_ = ps * 16 + (lane >> 2), c_ = (lane & 3) * 8; \
      float4 v0 = *(const float4*)(W + r_ * 36 + c_), v1 = *(const float4*)(W + r_ * 36 + c_ + 4); \
      u32x4 o_; o_[0] = pack2(v0.x, v0.y); o_[1] = pack2(v0.z, v0.w); o_[2] = pack2(v1.x, v1.y); o_[3] = pack2(v1.z, v1.w); \
      *GPTR(u32x4, (dstbase) + (long)r_ * (ld) + c_) = o_; } } while (0)
  if constexpr (EPI == EPI_PLAIN) {
    _Pragma("unroll") for (int ai = 0; ai < 2; ++ai) _Pragma("unroll") for (int bj = 0; bj < 2; ++bj) {
      SCHED;
      _Pragma("unroll") for (int m = 0; m < 4; ++m) _Pragma("unroll") for (int j = 0; j < 4; ++j) {
        const float rs = rstd_s[lrow0 + ai * HALF + m * 16 + fq * 4 + j];
        _Pragma("unroll") for (int n = 0; n < 2; ++n) W_WRITE(m, n, j, acc[ai][bj][m][n][j] * rs);
      }
      bfu* dst = g.outb + (long)(wrow0 + ai * HALF) * g.ldo + g.ocol0 + wcol0 + bj * HALF;
      W_STORE_BF16(dst, g.ldo);
    }
  } else if constexpr (EPI == EPI_SWA) {
    const bool isrope = bcol < 3072;
    const float qs = (bcol < 1536) ? 0.08838834764831845f : 1.0f;
    if (isrope) {
      const int pc0 = wcol0 - bcol;
      const int hsel = pc0 >> 6, dd0 = pc0 & 63;
      float* Wa = W; float* Wb = W + 32 * 36;
      _Pragma("unroll") for (int ai = 0; ai < 2; ++ai) _Pragma("unroll") for (int mh = 0; mh < 2; ++mh) {
        SCHED;
        _Pragma("unroll") for (int mm = 0; mm < 2; ++mm) _Pragma("unroll") for (int j = 0; j < 4; ++j) {
          const int m = mh * 2 + mm;
          const float rs = rstd_s[lrow0 + ai * HALF + m * 16 + fq * 4 + j] * qs;
          _Pragma("unroll") for (int n = 0; n < 2; ++n) {
            Wa[(mm * 16 + fq * 4 + j) * 36 + n * 16 + fr] = acc[ai][0][m][n][j] * rs;
            Wb[(mm * 16 + fq * 4 + j) * 36 + n * 16 + fr] = acc[ai][1][m][n][j] * rs;
          }
        }
        f32x4 cv[2][2], sv[2][2];
        _Pragma("unroll") for (int ps = 0; ps < 2; ++ps) {
          const int t = (wrow0 + ai * HALF + mh * 32 + ps * 16 + (lane >> 2)) & (TSEQ - 1);
          const int dcol = dd0 + (lane & 3) * 8;
          cv[ps][0] = *GPTR(const f32x4, g.rope + t * 64 + dcol); cv[ps][1] = *GPTR(const f32x4, g.rope + t * 64 + dcol + 4);
          sv[ps][0] = *GPTR(const f32x4, g.rope + TSEQ * 64 + t * 64 + dcol); sv[ps][1] = *GPTR(const f32x4, g.rope + TSEQ * 64 + t * 64 + dcol + 4);
        }
        _Pragma("unroll") for (int ps = 0; ps < 2; ++ps) {
          const int r_ = ps * 16 + (lane >> 2), c_ = (lane & 3) * 8;
          const int grow = wrow0 + ai * HALF + mh * 32 + r_;
          const float4 xa0 = *(const float4*)(Wa + r_ * 36 + c_), xa1 = *(const float4*)(Wa + r_ * 36 + c_ + 4);
          const float4 xb0 = *(const float4*)(Wb + r_ * 36 + c_), xb1 = *(const float4*)(Wb + r_ * 36 + c_ + 4);
          const f32x4 c0v = cv[ps][0], c1v = cv[ps][1], s0v = sv[ps][0], s1v = sv[ps][1];
          u32x4 y1, y2;
          y1[0] = pack2(xa0.x * c0v[0] - xb0.x * s0v[0], xa0.y * c0v[1] - xb0.y * s0v[1]);
          y1[1] = pack2(xa0.z * c0v[2] - xb0.z * s0v[2], xa0.w * c0v[3] - xb0.w * s0v[3]);
          y1[2] = pack2(xa1.x * c1v[0] - xb1.x * s1v[0], xa1.y * c1v[1] - xb1.y * s1v[1]);
          y1[3] = pack2(xa1.z * c1v[2] - xb1.z * s1v[2], xa1.w * c1v[3] - xb1.w * s1v[3]);
          y2[0] = pack2(xa0.x * s0v[0] + xb0.x * c0v[0], xa0.y * s0v[1] + xb0.y * c0v[1]);
          y2[1] = pack2(xa0.z * s0v[2] + xb0.z * c0v[2], xa0.w * s0v[3] + xb0.w * c0v[3]);
          y2[2] = pack2(xa1.x * s1v[0] + xb1.x * c1v[0], xa1.y * s1v[1] + xb1.y * c1v[1]);
          y2[3] = pack2(xa1.z * s1v[2] + xb1.z * c1v[2], xa1.w * s1v[3] + xb1.w * c1v[3]);
          bfu* dst = g.outb + (long)grow * g.ldo + bcol + hsel * 128 + dd0 + c_;
          *GPTR(u32x4, dst) = y1;
          *GPTR(u32x4, dst + 64) = y2;
        }
      }
    } else {
      _Pragma("unroll") for (int ai = 0; ai < 2; ++ai) _Pragma("unroll") for (int bj = 0; bj < 2; ++bj) {
        SCHED;
        _Pragma("unroll") for (int m = 0; m < 4; ++m) _Pragma("unroll") for (int j = 0; j < 4; ++j) {
          const float rs = rstd_s[lrow0 + ai * HALF + m * 16 + fq * 4 + j];
          _Pragma("unroll") for (int n = 0; n < 2; ++n) W_WRITE(m, n, j, acc[ai][bj][m][n][j] * rs);
        }
        bfu* dst = g.outb + (long)(wrow0 + ai * HALF) * g.ldo + wcol0 + bj * HALF;
        W_STORE_BF16(dst, g.ldo);
      }
    }
  } else if constexpr (EPI == EPI_GLU) {
    const int tn = bcol >> 8;
    _Pragma("unroll") for (int ai = 0; ai < 2; ++ai) {
      SCHED;
      _Pragma("unroll") for (int m = 0; m < 4; ++m) _Pragma("unroll") for (int j = 0; j < 4; ++j) {
        const float rs = rstd_s[lrow0 + ai * HALF + m * 16 + fq * 4 + j];
        _Pragma("unroll") for (int n = 0; n < 2; ++n) {
          const float gg = acc[ai][0][m][n][j] * rs, uu = acc[ai][1][m][n][j] * rs;
          W_WRITE(m, n, j, siluf_(gg) * uu);
        }
      }
      bfu* dst = g.outb + (long)(wrow0 + ai * HALF) * g.ldo + tn * 128 + (wcol0 - bcol);
      W_STORE_BF16(dst, g.ldo);
    }
  } else {
    _Pragma("unroll") for (int ai = 0; ai < 2; ++ai) {
      float ssp[8];
      _Pragma("unroll") for (int ps = 0; ps < 8; ++ps) ssp[ps] = 0.f;
      _Pragma("unroll") for (int bj = 0; bj < 2; ++bj) {
        SCHED;
        _Pragma("unroll") for (int m = 0; m < 4; ++m) _Pragma("unroll") for (int j = 0; j < 4; ++j)
          _Pragma("unroll") for (int n = 0; n < 2; ++n) W_WRITE(m, n, j, acc[ai][bj][m][n][j]);
        const long obase = (long)(wrow0 + ai * HALF + (lane >> 3)) * 1024 + wcol0 + bj * HALF + (lane & 7) * 4;
        if (g.res_bf16) {
          u32x2 hrv[8];
          _Pragma("unroll") for (int ps = 0; ps < 8; ++ps) hrv[ps] = *GPTR(const u32x2, g.hb + obase + (long)ps * 8 * 1024);
          _Pragma("unroll") for (int ps = 0; ps < 8; ++ps) {
            const int r_ = ps * 8 + (lane >> 3), c_ = (lane & 7) * 4;
            float4 v = *(const float4*)(W + r_ * 36 + c_);
            v.x += __uint_as_float(hrv[ps][0] << 16); v.y += __uint_as_float(hrv[ps][0] & 0xffff0000u);
            v.z += __uint_as_float(hrv[ps][1] << 16); v.w += __uint_as_float(hrv[ps][1] & 0xffff0000u);
            u32x2 hb2; hb2[0] = pack2(v.x, v.y); hb2[1] = pack2(v.z, v.w);
            *GPTR(u32x2, g.hb + obase + (long)ps * 8 * 1024) = hb2;
            ssp[ps] += v.x * v.x + v.y * v.y + v.z * v.z + v.w * v.w;
          }
        } else {
          _Pragma("unroll") for (int ps = 0; ps < 8; ++ps) {
            const int r_ = ps * 8 + (lane >> 3), c_ = (lane & 7) * 4;
            const long o = obase + (long)ps * 8 * 1024;
            float4 v = *(const float4*)(W + r_ * 36 + c_);
            const f32x4 hr = *GPTR(const f32x4, g.hres + o);
            v.x += hr[0]; v.y += hr[1]; v.z += hr[2]; v.w += hr[3];
            u32x2 hb2; hb2[0] = pack2(v.x, v.y); hb2[1] = pack2(v.z, v.w);
            *GPTR(u32x2, g.hb + o) = hb2;
            ssp[ps] += v.x * v.x + v.y * v.y + v.z * v.z + v.w * v.w;
          }
        }
      }
      _Pragma("unroll") for (int ps = 0; ps < 8; ++ps) {
        float ss = ssp[ps];
        ss += SHX(ss, 1); ss += SHX(ss, 2); ss += SHX(ss, 4);
        if ((lane & 7) == 0) *GPTR(float, g.rowss_next + (long)(wrow0 + ai * HALF + ps * 8 + (lane >> 3)) * 16 + (bcol >> 8) * 4 + wc) = ss;
      }
    }
  }
}

template <int EPI>
__device__ void gemm_phase(const GemmArgs& g, int nM, int nN, int extra_items, const Params& p, int L);

__device__ __forceinline__ int remap_block(int b, int G) { return (G % 8 == 0) ? ((b & 7) * (G >> 3) + (b >> 3)) : b; }

__device__ void ba_item(const Params& p, int L, int rp) {
  const float* misc = (const float*)(p.ws + MISC_OFF);
  float* miscw = (float*)(p.ws + MISC_OFF);
  const bfu* hb = (const bfu*)(p.ws + HB_OFF);
  const float* wba = misc + MF_WBA + (L >> 1) * 8192;
  const float* rowss = misc + MF_RSP + (L == 0 ? 0L : 2L * MTOK * 16);
  int tid = ptid_(p.tid); asm volatile("" : "+v"(tid));
  const int wid = tid >> 6, lane = tid & 63;
  f32x4 wr_[8][4];
  _Pragma("unroll") for (int j = 0; j < 8; ++j) _Pragma("unroll") for (int e4 = 0; e4 < 4; ++e4)
    wr_[j][e4] = *(const f32x4*)(wba + j * 1024 + lane * 16 + e4 * 4);
  for (int bt = 0; bt < 8; ++bt) {
    bf16x8 h0[2], h1[2]; f32x4 ps[2][4];
    _Pragma("unroll") for (int u = 0; u < 2; ++u) {
      const int row = rp * 128 + wid * 16 + bt * 2 + u;
      const bfu* hr = hb + (long)row * 1024 + lane * 16;
      h0[u] = *(const bf16x8*)hr; h1[u] = *(const bf16x8*)(hr + 8);
      _Pragma("unroll") for (int i = 0; i < 4; ++i) ps[u][i] = *(const f32x4*)(rowss + (long)row * 16 + i * 4);
    }
    _Pragma("unroll") for (int u = 0; u < 2; ++u) {
      const int row = rp * 128 + wid * 16 + bt * 2 + u;
      float hf[16];
      _Pragma("unroll") for (int e = 0; e < 8; ++e) { hf[e] = bf2f((bfu)h0[u][e]); hf[8 + e] = bf2f((bfu)h1[u][e]); }
      float a[8];
      _Pragma("unroll") for (int j = 0; j < 8; ++j) {
        float s = 0.f;
        _Pragma("unroll") for (int e4 = 0; e4 < 4; ++e4) _Pragma("unroll") for (int e = 0; e < 4; ++e) s += hf[e4 * 4 + e] * wr_[j][e4][e];
        _Pragma("unroll") for (int o = 32; o >= 1; o >>= 1) s += SHX(s, o);
        a[j] = s;
      }
      if (lane < 8) {
        float s16 = 0.f;
        _Pragma("unroll") for (int i = 0; i < 4; ++i) s16 += (ps[u][i][0] + ps[u][i][1]) + (ps[u][i][2] + ps[u][i][3]);
        float rs = frsq(s16 * (1.0f / 1024.0f) + 1e-6f);
        float v = 0.f;
        _Pragma("unroll") for (int j = 0; j < 8; ++j) if (lane == j) v = a[j];
        v *= rs;
        float r;
        if (lane < 4) r = sigmoidf_(v);
        else {
          int hh = lane - 4;
          float z = v + p.dn_dt_bias[(L >> 1) * 4 + hh];
          float sp = (z > 20.f) ? z : flog(1.0f + fexp(z));
          r = -fexp(p.dn_a_log[(L >> 1) * 4 + hh]) * sp;
        }
        miscw[MF_BG + (long)row * 8 + lane] = r;
      }
    }
  }
}

template <int EPI>
__device__ void gemm_phase(const GemmArgs& g, int nM, int nN, int extra_items, const Params& p, int L) {
  const int G = gridDim.x;
  const int total = nM * nN;
  const int rb = remap_block(p.bid, G);
  int par = 0;
  bool have = false;
  for (int v = rb; v < total + extra_items; v += G) {
    if (v < total) {
      const int nig = 8 * nN;
      int pm = (v / nig) * 8 + ((v % nig) & 7), pn = (v % nig) >> 3;
      const int nv = v + G; const bool nvalid = nv < total;
      const int npm = (nv / nig) * 8 + ((nv % nig) & 7), npn = (nv % nig) >> 3;
      gemm_tile<EPI>(g, pm * BM, pn * BM, par++, !have, nvalid, npm * BM, npn * BM);
      have = nvalid;
    } else {
      ba_item(p, L, v - total);
    }
  }
}

struct CvtJob { const float* src0; const float* src1; int ld; int kind; const float* gain; long dst; int N; int K; };

__device__ CvtJob get_job(const Params& p, int L, int j) {
  CvtJob c{}; int i = L >> 1; long base = wt_base(L);
  if ((L & 1) == 0) {
    if (j == 0) { c.src0 = p.ab_w_in + (long)i * 1024 * 3592; c.ld = 3592; c.kind = 1; c.gain = p.norm_mix_g + L * 1024; c.dst = base; c.N = 3584; c.K = 1024; }
    else if (j == 1) { c.src0 = p.ab_w_out + (long)i * 1024 * 1024; c.ld = 1024; c.kind = 0; c.gain = nullptr; c.dst = base + 3584L * 1024; c.N = 1024; c.K = 1024; }
    else if (j == 2) { c.src0 = p.ffn_w_gate + (long)L * 1024 * 2816; c.src1 = p.ffn_w_up + (long)L * 1024 * 2816; c.ld = 2816; c.kind = 3; c.gain = p.norm_ffn_g + L * 1024; c.dst = base + 4608L * 1024; c.N = 5632; c.K = 1024; }
    else if (j == 3) { c.src0 = p.ffn_w_down + (long)L * 2816 * 1024; c.ld = 1024; c.kind = 0; c.gain = nullptr; c.dst = base + 10240L * 1024; c.N = 1024; c.K = 2816; }
    else { c.N = 0; c.K = 64; }
  } else {
    if (j == 0) { c.src0 = p.cd_w_in + (long)i * 1024 * 6656; c.ld = 6656; c.kind = 2; c.gain = p.norm_mix_g + L * 1024; c.dst = base; c.N = 4608; c.K = 1024; }
    else if (j == 1) { c.src0 = p.cd_w_in + (long)i * 1024 * 6656; c.ld = 6656; c.kind = 0; c.gain = p.norm_mix_g + L * 1024; c.dst = base + 4608L * 1024; c.N = 2048; c.K = 1024; }
    else if (j == 2) { c.src0 = p.cd_w_out + (long)i * 1024 * 1024; c.ld = 1024; c.kind = 0; c.gain = nullptr; c.dst = base + 6656L * 1024; c.N = 1024; c.K = 1024; }
    else if (j == 3) { c.src0 = p.ffn_w_gate + (long)L * 1024 * 2816; c.src1 = p.ffn_w_up + (long)L * 1024 * 2816; c.ld = 2816; c.kind = 3; c.gain = p.norm_ffn_g + L * 1024; c.dst = base + 7680L * 1024; c.N = 5632; c.K = 1024; }
    else { c.src0 = p.ffn_w_down + (long)L * 2816 * 1024; c.ld = 1024; c.kind = 0; c.gain = nullptr; c.dst = base + 13312L * 1024; c.N = 1024; c.K = 2816; }
  }
  return c;
}

__device__ void cvt_tile(const CvtJob& c, int tile, bfu* wt, const int tid_) {
  float* ts = (float*)smem;
  const int nk = c.K / 256;
  const int tn = tile / nk, tk = tile % nk;
  const int n0 = tn * 64, k0 = tk * 256;
  const float* src = c.src0; int l0;
  if (c.kind == 0) l0 = n0;
  else if (c.kind == 1) l0 = (n0 < 2048) ? n0 : n0 + 8;
  else if (c.kind == 2) {
    if (n0 < 3072) { int tl = n0 >> 8, w = n0 & 255, bj = w >> 7, hsel = (w & 127) >> 6; l0 = 2048 + tl * 256 + hsel * 128 + bj * 64; }
    else l0 = 2048 + n0;
  } else { int tl = n0 >> 8, w = n0 & 255; src = (w < 128) ? c.src0 : c.src1; l0 = tl * 128 + (w & 127); }
  const int tid = tid_;
  __syncthreads();
  { f32x4 v[8];
    _Pragma("unroll") for (int i = 0; i < 8; ++i) { const int idx = tid + 512 * i; const int kk = idx >> 4, n4 = idx & 15;
      v[i] = *GPTR(const f32x4, src + (long)(k0 + kk) * c.ld + l0 + n4 * 4); }
    _Pragma("unroll") for (int i = 0; i < 8; ++i) { const int idx = tid + 512 * i; const int kk = idx >> 4, n4 = idx & 15;
      const float gsc = c.gain ? c.gain[k0 + kk] : 1.0f;
      _Pragma("unroll") for (int e = 0; e < 4; ++e) ts[kk * 65 + n4 * 4 + e] = v[i][e] * gsc; } }
  __syncthreads();
  { _Pragma("unroll") for (int i = 0; i < 4; ++i) { const int idx = tid + 512 * i;
      const int ch = ((idx >> 6) & 3) * 8 + (idx & 7), n = (idx >> 8) * 8 + ((idx >> 3) & 7);
      u32x4 o_;
      _Pragma("unroll") for (int e = 0; e < 4; ++e) o_[e] = pack2(ts[(ch * 8 + 2 * e) * 65 + n], ts[(ch * 8 + 2 * e + 1) * 65 + n]);
      *GPTR(u32x4, wt + c.dst + (long)(n0 + n) * c.K + k0 + ch * 8) = o_; } }
}
__device__ void cvt_jobs(const Params& p, int L0, int j0, int L1, int j1, int vb, int VG) {
  bfu* wt = (bfu*)(p.ws + WT_OFF);
  int tbase = 0;
  for (int L = L0; L <= L1; ++L) {
    const int ja = (L == L0) ? j0 : 0, jb = (L == L1) ? j1 : 4;
    for (int j = ja; j <= jb; ++j) {
      CvtJob c = get_job(p, L, j);
      int ntile = (c.N / 64) * (c.K / 256);
      int first = ((vb - tbase) % VG + VG) % VG;
      for (int t = first; t < ntile; t += VG) cvt_tile(c, t, wt, ptid_(p.tid));
      tbase = (tbase + ntile) % VG;
    }
  }
}

__device__ void phase_prologue(const Params& p) {
  float* misc = (float*)(p.ws + MISC_OFF);
  bfu* hb = (bfu*)(p.ws + HB_OFF);
  const int G = gridDim.x, tid = ptid_(p.tid), wid = tid >> 6, lane = tid & 63;
  const long gtid = (long)p.bid * NTHR + tid, gstride = (long)G * NTHR;

  for (long i = gtid; i < 1024; i += gstride) {
    int li = (int)(i >> 9), c = (int)(i & 511);
    float a = p.hg_lb[c], b = p.hg_lb[512 + c];
    float mx = fmaxf(a, b); float ea = fexp(a - mx), eb = fexp(b - mx);
    misc[MF_LB + i] = (li == 0) ? 0.f : eb * frcp(ea + eb);
  }
  for (long i = gtid; i < 16384; i += gstride) {
    int li = (int)(i >> 13), j = (int)((i >> 10) & 7), k = (int)(i & 1023);
    misc[MF_WBA + i] = p.norm_mix_g[(2 * li) * 1024 + k] * p.ab_w_in[(long)li * 1024 * 3592 + (long)k * 3592 + 2048 + j];
  }
  for (long i = gtid; i < (long)TSEQ * 64; i += gstride) {
    int t = (int)(i >> 6), dd = (int)(i & 63);
    float invf = __builtin_amdgcn_exp2f(-(float)dd * (13.287712379549449f / 64.0f));
    if (dd == 0) invf = 1.0f;
    double rev = (double)t * (double)invf * 0.15915494309189535;
    float fr = (float)(rev - floor(rev));
    misc[MF_ROPE + i] = __builtin_amdgcn_cosf(fr);
    misc[MF_ROPE + TSEQ * 64 + i] = __builtin_amdgcn_sinf(fr);
  }
  for (int r0 = (p.bid * 8 + wid) * 4; r0 < MTOK; r0 += G * 32) {
    f32x4 xa[4][4];
    _Pragma("unroll") for (int u = 0; u < 4; ++u) _Pragma("unroll") for (int i = 0; i < 4; ++i)
      xa[u][i] = *(const f32x4*)(p.x + (long)(r0 + u) * 1024 + lane * 16 + i * 4);
    _Pragma("unroll") for (int u = 0; u < 4; ++u) {
      const int row = r0 + u;
      float ss = 0.f;
      _Pragma("unroll") for (int i = 0; i < 4; ++i) _Pragma("unroll") for (int e = 0; e < 4; ++e) ss += xa[u][i][e] * xa[u][i][e];
      u32x4 o0, o1;
      o0[0] = pack2(xa[u][0][0], xa[u][0][1]); o0[1] = pack2(xa[u][0][2], xa[u][0][3]); o0[2] = pack2(xa[u][1][0], xa[u][1][1]); o0[3] = pack2(xa[u][1][2], xa[u][1][3]);
      o1[0] = pack2(xa[u][2][0], xa[u][2][1]); o1[1] = pack2(xa[u][2][2], xa[u][2][3]); o1[2] = pack2(xa[u][3][0], xa[u][3][1]); o1[3] = pack2(xa[u][3][2], xa[u][3][3]);
      *(u32x4*)(hb + (long)row * 1024 + lane * 16) = o0;
      *(u32x4*)(hb + (long)row * 1024 + lane * 16 + 8) = o1;
      for (int o = 32; o >= 1; o >>= 1) ss += SHX(ss, o);
      if (lane < 16) misc[MF_RSP + (long)row * 16 + lane] = (lane == 0) ? ss : 0.f;
    }
  }
  cvt_jobs(p, 0, 0, 0, 0, p.bid, G);
}

__device__ __forceinline__ int fragA_128(int r, int k) { return ((r >> 4) * 4 + (k >> 5)) * 512 + ((k >> 3) & 3) * 128 + (r & 15) * 8 + (k & 7); }
__device__ __forceinline__ int fragA_64(int r, int k) { return ((r >> 4) * 2 + (k >> 5)) * 512 + ((k >> 3) & 3) * 128 + (r & 15) * 8 + (k & 7); }
__device__ __forceinline__ int fragC_128(int r, int cidx) { return ((r >> 4) * 8 + (cidx >> 4)) * 256 + (((r & 15) >> 2)) * 64 + (cidx & 15) * 4 + (r & 3); }
__device__ __forceinline__ bfu* dnp_item(const Params& p, int idx) {
  return (idx < 1820) ? ((bfu*)p.out + (long)idx * 36864) : ((bfu*)(p.ws + R_OFF) + (long)(idx - 1820) * 36864);
}
__device__ void dn_pre_item(const Params& p, int L, int idx) {
  const int li = L >> 1;
  float* misc = (float*)(p.ws + MISC_OFF);
  const bfu* pab = (const bfu*)(p.ws + PAB_OFF);
  bfu* dnp = dnp_item(p, idx);
  const int b = idx >> 8, h = (idx >> 6) & 3, n = idx & 63;
  const long R0 = (long)b * TSEQ + n * 64;
  int zoff = 0; asm volatile("" : "+v"(zoff));
  unsigned char* sb = smem + zoff;
  float* As = (float*)sb; float* gcs = As + 64 * 65; float* betas = gcs + 64; float* egc = betas + 64;
  float* qs = (float*)(sb + 17408); float* ks = (float*)(sb + 51200); float* vs = (float*)(sb + 84992);
  bfu* kb = (bfu*)(sb + 118784); bfu* qb = (bfu*)(sb + 136192);
  float* Tf = (float*)(sb + 17408); bfu* Tb = (bfu*)(sb + 34048); float* Mt = (float*)(sb + 43264);
  bfu* rhsT = (bfu*)(sb + 118784);
  int tid = ptid_(p.tid); asm volatile("" : "+v"(tid)); const int wid = tid >> 6, lane = tid & 63;
  const int c16 = lane & 15, q4 = lane >> 4;
  __syncthreads();
  float gv_pre = 0.f, be_pre = 0.f;
  if (wid == 0) { gv_pre = misc[MF_BG + (R0 + lane) * 8 + 4 + h]; be_pre = misc[MF_BG + (R0 + lane) * 8 + h]; }
  { const int c = tid & 127, rg = tid >> 7;
    const int r0 = rg * 16;
    const bool head0 = (n == 0) && (rg == 0);
    bfu xr[3][19]; float cwv[3][4];
    _Pragma("unroll") for (int mat = 0; mat < 3; ++mat) {
      const int colp = mat * 512 + h * 128 + c;
      const float* cw = p.dn_conv_w + (long)li * 4 * 1536 + colp;
      _Pragma("unroll") for (int jw = 0; jw < 4; ++jw) cwv[mat][jw] = cw[jw * 1536];
      _Pragma("unroll") for (int i = 0; i < 19; ++i) {
        const long rr = R0 + r0 - 3 + i;
        xr[mat][i] = pab[((i < 3 && head0) ? R0 : rr) * 3584 + colp];
      }
    }
    _Pragma("unroll") for (int mat = 0; mat < 3; ++mat) {
      float* dst = (mat == 0) ? qs : (mat == 1 ? ks : vs);
      float xm3 = head0 ? 0.f : bf2f(xr[mat][0]), xm2 = head0 ? 0.f : bf2f(xr[mat][1]), xm1 = head0 ? 0.f : bf2f(xr[mat][2]);
      _Pragma("unroll") for (int r = 0; r < 16; ++r) {
        const float x0 = bf2f(xr[mat][3 + r]);
        const float y = cwv[mat][0] * xm3 + cwv[mat][1] * xm2 + cwv[mat][2] * xm1 + cwv[mat][3] * x0;
        dst[(r0 + r) * 132 + c] = siluf_(y);
        xm3 = xm2; xm2 = xm1; xm1 = x0;
      }
    }
  }
  __syncthreads();
  { const int rowid = tid >> 2, part = tid & 3;
    const bool isq = rowid < 64; const int rr = isq ? rowid : rowid - 64;
    float* base = (isq ? qs : ks) + rr * 132;
    bfu* bb = (isq ? qb : kb) + rr * 136;
    float ss = 0.f;
    for (int i = 0; i < 32; ++i) { float v = base[part + 4 * i]; ss += v * v; }
    ss += SHX(ss, 1); ss += SHX(ss, 2);
    float sc = frsq(ss + 1e-6f) * (isq ? 0.08838834764831845f : 1.0f);
    for (int i = 0; i < 32; ++i) { float v = base[part + 4 * i] * sc; base[part + 4 * i] = v; bb[part + 4 * i] = f2bf(v); }
  }
  if (wid == 0) {
    float gv = gv_pre;
    for (int o = 1; o < 64; o <<= 1) { float t = shup_(gv, o, lane); if (lane >= o) gv += t; }
    gcs[lane] = gv; egc[lane] = fexp(gv);
    betas[lane] = be_pre;
  }
  __syncthreads();
  for (int i = 0; i < 4; ++i) {
    const int id = wid * 4 + i; const int mat = id >> 4, rt = (id & 15) >> 2, ct = id & 3;
    f32x4 a = (f32x4){0.f, 0.f, 0.f, 0.f};
    if (ct <= rt) {
      _Pragma("unroll") for (int kk = 0; kk < 4; ++kk) {
        bf16x8 rf = *(const bf16x8*)((mat == 0 ? kb : qb) + (rt * 16 + c16) * 136 + kk * 32 + q4 * 8);
        bf16x8 cf = *(const bf16x8*)(kb + (ct * 16 + c16) * 136 + kk * 32 + q4 * 8);
        if (mat == 0) a = __builtin_amdgcn_mfma_f32_16x16x32_bf16(rf, cf, a, 0, 0, 0);
        else a = __builtin_amdgcn_mfma_f32_16x16x32_bf16(cf, rf, a, 0, 0, 0);
      }
    }
    if (mat == 0) {
      const int s = ct * 16 + c16;
      _Pragma("unroll") for (int j = 0; j < 4; ++j) {
        const int row = rt * 16 + q4 * 4 + j;
        float dec = (s <= row) ? fexp(gcs[row] - gcs[s]) : 0.f;
        As[row * 65 + s] = (s < row) ? betas[row] * a[j] * dec : 0.f;
      }
    } else {
      const int row = rt * 16 + c16; const int s0 = ct * 16 + q4 * 4;
      float v[4];
      _Pragma("unroll") for (int j = 0; j < 4; ++j) { const int s = s0 + j; v[j] = (s <= row) ? a[j] * fexp(gcs[row] - gcs[s]) : 0.f; }
      u32x2 o2; o2[0] = pack2(v[0], v[1]); o2[1] = pack2(v[2], v[3]);
      *(u32x2*)(dnp + 32768 + (rt * 2 + (s0 >> 5)) * 512 + ((s0 >> 3) & 3) * 128 + c16 * 8 + (s0 & 7)) = o2;
    }
  }
  _Pragma("unroll") for (int i2 = 0; i2 < 2; ++i2) {
    const int blk = wid + 8 * i2;
    { const int rt = blk >> 2, kk = blk & 3; const int row = rt * 16 + c16, k = kk * 32 + q4 * 8;
      const float4 x0 = *(const float4*)(qs + row * 132 + k), x1 = *(const float4*)(qs + row * 132 + k + 4);
      const float eg = egc[row];
      u32x4 o4; o4[0] = pack2(x0.x * eg, x0.y * eg); o4[1] = pack2(x0.z * eg, x0.w * eg); o4[2] = pack2(x1.x * eg, x1.y * eg); o4[3] = pack2(x1.z * eg, x1.w * eg);
      *(u32x4*)(dnp + 16384 + blk * 512 + lane * 8) = o4; }
    { const int dt = blk >> 1, k2 = blk & 1; const int d = dt * 16 + c16, s0 = k2 * 32 + q4 * 8;
      float v[8];
      _Pragma("unroll") for (int e = 0; e < 8; ++e) v[e] = ks[(s0 + e) * 132 + d] * fexp(gcs[63] - gcs[s0 + e]);
      u32x4 o4; o4[0] = pack2(v[0], v[1]); o4[1] = pack2(v[2], v[3]); o4[2] = pack2(v[4], v[5]); o4[3] = pack2(v[6], v[7]);
      *(u32x4*)(dnp + 24576 + blk * 512 + lane * 8) = o4; }
  }
  if (tid == 0) misc[MF_GTOT + idx] = egc[63];
  __syncthreads();
  if (wid == 0) {
    const int blk = lane >> 5, j = lane & 31;
    const float* Ab = As + (blk * 32) * 65 + blk * 32;
    float x[32];
#pragma unroll
    for (int c = 0; c < 32; ++c) {
      float r = (c == j) ? 1.0f : 0.0f;
#pragma unroll
      for (int s = 0; s < c; ++s) r -= Ab[c * 65 + s] * x[s];
      x[c] = r;
    }
#pragma unroll
    for (int c = 0; c < 32; ++c) Tf[(blk * 32 + c) * 65 + blk * 32 + j] = x[c];
  } else {
    for (int e = tid - 64; e < 16384; e += 448) {
      const int col = e >> 6, s = e & 63;
      float v = (col < 128) ? betas[s] * vs[s * 132 + col] : betas[s] * egc[s] * ks[s * 132 + (col - 128)];
      rhsT[col * 72 + s] = f2bf(v);
    }
  }
  __syncthreads();
  { const int i = tid >> 4, j0 = (tid & 15) * 2;
    float m0 = 0.f, m1 = 0.f;
    for (int k = 0; k < 32; ++k) { float av = As[(32 + i) * 65 + k]; m0 += av * Tf[k * 65 + j0]; m1 += av * Tf[k * 65 + j0 + 1]; }
    Mt[i * 33 + j0] = m0; Mt[i * 33 + j0 + 1] = m1;
  }
  __syncthreads();
  { const int i = tid >> 4, j0 = (tid & 15) * 2;
    float t0 = 0.f, t1 = 0.f;
    for (int k = 0; k < 32; ++k) { float tv = Tf[(32 + i) * 65 + 32 + k]; t0 += tv * Mt[k * 33 + j0]; t1 += tv * Mt[k * 33 + j0 + 1]; }
    Tb[(32 + i) * 72 + j0] = f2bf(-t0); Tb[(32 + i) * 72 + j0 + 1] = f2bf(-t1);
    Tb[i * 72 + j0] = f2bf(Tf[i * 65 + j0]); Tb[i * 72 + j0 + 1] = f2bf(Tf[i * 65 + j0 + 1]);
    Tb[i * 72 + 32 + j0] = 0; Tb[i * 72 + 32 + j0 + 1] = 0;
    Tb[(32 + i) * 72 + 32 + j0] = f2bf(Tf[(32 + i) * 65 + 32 + j0]); Tb[(32 + i) * 72 + 32 + j0 + 1] = f2bf(Tf[(32 + i) * 65 + 32 + j0 + 1]);
  }
  __syncthreads();
  { bf16x8 tf[4][2];
    _Pragma("unroll") for (int rt = 0; rt < 4; ++rt) _Pragma("unroll") for (int k2 = 0; k2 < 2; ++k2)
      tf[rt][k2] = *(const bf16x8*)(Tb + (rt * 16 + c16) * 72 + k2 * 32 + q4 * 8);
    _Pragma("unroll") for (int cc = 0; cc < 2; ++cc) {
      const int ct = wid * 2 + cc;
      bf16x8 bf[2];
      _Pragma("unroll") for (int k2 = 0; k2 < 2; ++k2) bf[k2] = *(const bf16x8*)(rhsT + (ct * 16 + c16) * 72 + k2 * 32 + q4 * 8);
      _Pragma("unroll") for (int rt = 0; rt < 4; ++rt) {
        f32x4 a = (f32x4){0.f, 0.f, 0.f, 0.f};
        if (ct < 8) {
          _Pragma("unroll") for (int k2 = 0; k2 < 2; ++k2) a = __builtin_amdgcn_mfma_f32_16x16x32_bf16(tf[rt][k2], bf[k2], a, 0, 0, 0);
          u32x2 o2; o2[0] = pack2(a[0], a[1]); o2[1] = pack2(a[2], a[3]);
          *(u32x2*)(dnp + 8192 + ((rt * 8 + ct) * 64 + lane) * 4) = o2;
        } else {
          _Pragma("unroll") for (int k2 = 0; k2 < 2; ++k2) a = __builtin_amdgcn_mfma_f32_16x16x32_bf16(bf[k2], tf[rt][k2], a, 0, 0, 0);
          const int k0 = (ct - 8) * 16 + q4 * 4;
          u32x2 o2; o2[0] = pack2(-a[0], -a[1]); o2[1] = pack2(-a[2], -a[3]);
          *(u32x2*)(dnp + (rt * 4 + (k0 >> 5)) * 512 + ((k0 >> 3) & 3) * 128 + c16 * 8 + (k0 & 7)) = o2;
        }
      }
    }
  }
}

__device__ void dn_scan_block(const Params& p, int L, int item) {
  float* misc = (float*)(p.ws + MISC_OFF);
  bfu* pab = (bfu*)(p.ws + PAB_OFF);
  const int bh = item >> 2, qt = item & 3;

  int tid = ptid_(p.tid); asm volatile("" : "+v"(tid));
  const int w = tid >> 6, lane = tid & 63, c = lane & 15, q = lane >> 4;
  const int rt = w >> 1, ct = w & 1, dt = w;
  bfu* St = (bfu*)smem;
  bfu* ut = St + 2 * 2176;
  const int b = bh >> 2, h = bh & 3;
  __syncthreads();
  for (int i = tid; i < 2 * 2176; i += NTHR) St[i] = 0;
  f32x4 Sacc[2];
  Sacc[0] = (f32x4){0.f, 0.f, 0.f, 0.f}; Sacc[1] = Sacc[0];
#define DN_DECL(X) bf16x8 nw##X[4], qd##X[4], qk##X[2], kd##X[2]; float ub##X[4]; float gt##X;
  DN_DECL(A) DN_DECL(B) DN_DECL(C)
#define DN_LOAD(X, nn) do { const bfu* cb0 = dnp_item(p, bh * 64 + (nn)); const bfu* cb = cb0 + lane * 8; \
    _Pragma("unroll") for (int kk = 0; kk < 4; ++kk) { nw##X[kk] = *(const bf16x8*)(cb + (rt * 4 + kk) * 512); \
                                 qd##X[kk] = *(const bf16x8*)(cb + 16384 + (rt * 4 + kk) * 512); } \
    _Pragma("unroll") for (int k2 = 0; k2 < 2; ++k2) { qk##X[k2] = *(const bf16x8*)(cb + 32768 + (rt * 2 + k2) * 512); \
                                 kd##X[k2] = *(const bf16x8*)(cb + 24576 + (dt * 2 + k2) * 512); } \
    { const u32x2 uu = *(const u32x2*)(cb0 + 8192 + ((rt * 8 + qt * 2 + ct) * 64 + lane) * 4); \
      ub##X[0] = bf2f((bfu)(uu[0] & 0xffffu)); ub##X[1] = bf2f((bfu)(uu[0] >> 16)); ub##X[2] = bf2f((bfu)(uu[1] & 0xffffu)); ub##X[3] = bf2f((bfu)(uu[1] >> 16)); } \
    gt##X = misc[MF_GTOT + bh * 64 + (nn)]; } while (0)
#define DN_STEP(X, n) do { \
    bf16x8 bS[4]; \
    _Pragma("unroll") for (int kk = 0; kk < 4; ++kk) bS[kk] = *(const bf16x8*)(St + ct * 2176 + c * 136 + kk * 32 + q * 8); \
    f32x4 u, o; \
    _Pragma("unroll") for (int j = 0; j < 4; ++j) u[j] = ub##X[j]; \
    o = (f32x4){0.f, 0.f, 0.f, 0.f}; \
    _Pragma("unroll") for (int kk = 0; kk < 4; ++kk) { \
      u = __builtin_amdgcn_mfma_f32_16x16x32_bf16(nw##X[kk], bS[kk], u, 0, 0, 0); \
      o = __builtin_amdgcn_mfma_f32_16x16x32_bf16(qd##X[kk], bS[kk], o, 0, 0, 0); } \
    { uint2 uo; uo.x = pack2(u[0], u[1]); uo.y = pack2(u[2], u[3]); \
      *(uint2*)(ut + ct * 1152 + c * 72 + rt * 16 + q * 4) = uo; } \
    LBAR; \
    bf16x8 bU[2][2]; \
    _Pragma("unroll") for (int cc = 0; cc < 2; ++cc) _Pragma("unroll") for (int k2 = 0; k2 < 2; ++k2) \
      bU[cc][k2] = *(const bf16x8*)(ut + cc * 1152 + c * 72 + k2 * 32 + q * 8); \
    _Pragma("unroll") for (int k2 = 0; k2 < 2; ++k2) { \
      bf16x8 bsel = *(const bf16x8*)(ut + ct * 1152 + c * 72 + k2 * 32 + q * 8); \
      o = __builtin_amdgcn_mfma_f32_16x16x32_bf16(qk##X[k2], bsel, o, 0, 0, 0); } \
    _Pragma("unroll") for (int j = 0; j < 4; ++j) { \
      long row = (long)b * TSEQ + (n) * 64 + rt * 16 + q * 4 + j; \
      pab[row * 3584 + h * 128 + qt * 32 + ct * 16 + c] = f2bf(o[j]); } \
    _Pragma("unroll") for (int cc = 0; cc < 2; ++cc) { \
      f32x4 a = Sacc[cc] * gt##X; \
      _Pragma("unroll") for (int k2 = 0; k2 < 2; ++k2) a = __builtin_amdgcn_mfma_f32_16x16x32_bf16(kd##X[k2], bU[cc][k2], a, 0, 0, 0); \
      Sacc[cc] = a; \
      uint2 so; so.x = pack2(a[0], a[1]); so.y = pack2(a[2], a[3]); \
      *(uint2*)(St + cc * 2176 + c * 136 + dt * 16 + q * 4) = so; } \
    LBAR; } while (0)
  DN_LOAD(A, 0); DN_LOAD(B, 1);
  __syncthreads();
  for (int n = 0; n < 63; n += 3) {
    DN_LOAD(C, n + 2); DN_STEP(A, n);
    DN_LOAD(A, n + 3); DN_STEP(B, n + 1);
    if (n + 4 < 64) DN_LOAD(B, n + 4);
    DN_STEP(C, n + 2);
  }
  DN_STEP(A, 63);
}

__device__ void ab_fin_rows(const Params& p, int L, int row0, int nrows, const bool doA, const bool doB) {
  const int li = L >> 1;
  bfu* pab = (bfu*)(p.ws + PAB_OFF);
  int tid = ptid_(p.tid); asm volatile("" : "+v"(tid)); const int wid = tid >> 6, lane = tid & 63;
  for (int rr = wid; rr < nrows; rr += 8) {
    const long row = row0 + rr;
    const int t = (int)(row & (TSEQ - 1));
    bfu* pr = pab + row * 3584;
    const int c0 = lane * 8;
    if (doA) {
    bf16x8 o = *(const bf16x8*)(pr + c0);
    bf16x8 z = *(const bf16x8*)(pr + 1536 + c0);
    float of[8]; float ss = 0.f;
    for (int e = 0; e < 8; ++e) { of[e] = bf2f((bfu)o[e]); ss += of[e] * of[e]; }
    ss += SHX(ss, 1); ss += SHX(ss, 2); ss += SHX(ss, 4); ss += SHX(ss, 8);
    const float rs = frsq(ss * (1.0f / 128.0f) + 1e-6f);
    float ra[8];
    for (int e = 0; e < 8; ++e) ra[e] = of[e] * rs * p.dn_norm_g[li * 128 + ((c0 + e) & 127)] * siluf_(bf2f((bfu)z[e]));
    uint4 wa; wa.x = pack2(ra[0], ra[1]); wa.y = pack2(ra[2], ra[3]); wa.z = pack2(ra[4], ra[5]); wa.w = pack2(ra[6], ra[7]);
    *(uint4*)(pr + 512 + c0) = wa;
    }
    if (doB) {
    bf16x8 gb = *(const bf16x8*)(pr + 2048 + c0);
    float rb[8];
    for (int e = 0; e < 8; ++e) rb[e] = 0.f;
    for (int j = 0; j < 3; ++j) {
      int tt = t - 2 + j;
      if (tt >= 0) {
        const bfu* pj = pab + (row - 2 + j) * 3584;
        bf16x8 gc = *(const bf16x8*)(pj + 2560 + c0);
        bf16x8 si = *(const bf16x8*)(pj + 3072 + c0);
        for (int e = 0; e < 8; ++e) rb[e] += p.sc_conv_w[(long)li * 3 * 512 + j * 512 + c0 + e] * (bf2f((bfu)gc[e]) * bf2f((bfu)si[e]));
      }
    }
    for (int e = 0; e < 8; ++e) rb[e] *= bf2f((bfu)gb[e]);
    uint4 wb; wb.x = pack2(rb[0], rb[1]); wb.y = pack2(rb[2], rb[3]); wb.z = pack2(rb[4], rb[5]); wb.w = pack2(rb[6], rb[7]);
    *(uint4*)(pr + 1024 + c0) = wb;
    }
  }
}

__device__ void swa_item(const Params& p, int item) {
  float* misc = (float*)(p.ws + MISC_OFF);
  bfu* buf = (bfu*)(p.ws + R_OFF);
  const int pat = item >> 10; const int rem = item & 1023;
  const int b = rem >> 7, head = (rem >> 5) & 3, sub = rem & 31;
  const int dil = (pat == 0) ? 1 : (pat == 1 ? 4 : 16);
  const int nqb = 32 / dil;
  const int r = sub / nqb, qb = sub % nqb;
  int tid = ptid_(p.tid); asm volatile("" : "+v"(tid)); const int w = tid >> 6, lane = tid & 63, c = lane & 15, q = lane >> 4;
  bfu* Vt = (bfu*)smem;
  bfu* Ks = Vt + 128 * 280;
  bfu* Pl = Ks + w * (16 * 168);
  const long rowb = (long)b * TSEQ;
  const int qcol = pat * 512 + head * 128, kcol = 1536 + qcol, vcol = 3072 + qcol;
  __syncthreads();
  _Pragma("unroll") for (int i = 0; i < 4; ++i) {
    int co = tid + 512 * i; int c8 = co & 15, kp = co >> 4;
    int j0 = qb * 128 - 128 + 2 * kp;
    const int j0c = (j0 >= 0) ? j0 : 0;
    bf16x8 v0 = *(const bf16x8*)(buf + (rowb + (long)j0c * dil + r) * 4608 + vcol + c8 * 8);
    bf16x8 v1 = *(const bf16x8*)(buf + (rowb + (long)(j0c + 1) * dil + r) * 4608 + vcol + c8 * 8);
    if (j0 < 0) { v0 = (bf16x8){0, 0, 0, 0, 0, 0, 0, 0}; v1 = v0; }
    const int chs = ((kp >> 2) ^ c8) * 8 + ((2 * kp) & 7);
    _Pragma("unroll") for (int e = 0; e < 8; ++e)
      *(unsigned*)(Vt + (c8 * 8 + e) * 280 + chs) = (unsigned)(bfu)v0[e] | ((unsigned)(bfu)v1[e] << 16);
  }
  _Pragma("unroll") for (int i = 0; i < 8; ++i) {
    int co = tid + 512 * i; int c8 = co & 15, kj = co >> 4;
    int j = qb * 128 - 128 + kj; j = (j >= 0) ? j : 0;
    *(bf16x8*)(Ks + kj * 136 + c8 * 8) = *(const bf16x8*)(buf + (rowb + (long)j * dil + r) * 4608 + kcol + c8 * 8);
  }
  for (int i = tid; i < 128 * 12; i += NTHR) { int dv = i / 12, k2 = i % 12; *(unsigned*)(Vt + dv * 280 + 256 + 2 * k2) = 0u; }
  bf16x8 qf[4];
  { long qrow = rowb + (long)(qb * 128 + w * 16 + c) * dil + r;
    _Pragma("unroll") for (int kk = 0; kk < 4; ++kk) qf[kk] = *(const bf16x8*)(buf + qrow * 4608 + qcol + kk * 32 + q * 8); }
  __syncthreads();
  f32x4 S[9];
  _Pragma("unroll") for (int ci = 0; ci < 9; ++ci) {
    const int ct = w + ci;
    f32x4 a = (f32x4){0.f, 0.f, 0.f, 0.f};
    _Pragma("unroll") for (int kk = 0; kk < 4; ++kk) {
      bf16x8 kf = *(const bf16x8*)(Ks + (ct * 16 + c) * 136 + kk * 32 + q * 8);
      a = __builtin_amdgcn_mfma_f32_16x16x32_bf16(qf[kk], kf, a, 0, 0, 0);
    }
    S[ci] = a;
  }
  float mx[4], ls[4];
  _Pragma("unroll") for (int jj = 0; jj < 4; ++jj) {
    const int qi = w * 16 + q * 4 + jj;
    float m = -1e30f;
    _Pragma("unroll") for (int ci = 0; ci < 9; ++ci) {
      int kj = (w + ci) * 16 + c; int dist = qi + 128 - kj;
      bool valid = (dist >= 0) && (dist <= 128) && (qb > 0 || kj >= 128);
      float s = valid ? S[ci][jj] : -1e30f;
      S[ci][jj] = s; m = fmaxf(m, s);
    }
    m = fmaxf(m, SHX(m, 1)); m = fmaxf(m, SHX(m, 2)); m = fmaxf(m, SHX(m, 4)); m = fmaxf(m, SHX(m, 8));
    float l = 0.f;
    _Pragma("unroll") for (int ci = 0; ci < 9; ++ci) {
      float s = S[ci][jj];
      float pv = (s > -1e29f) ? fexp(s - m) : 0.f;
      S[ci][jj] = pv; l += pv;
    }
    l += SHX(l, 1); l += SHX(l, 2); l += SHX(l, 4); l += SHX(l, 8);
    mx[jj] = m; ls[jj] = l;
  }
  __syncthreads();
  _Pragma("unroll") for (int ci = 0; ci < 9; ++ci) _Pragma("unroll") for (int jj = 0; jj < 4; ++jj) Pl[(q * 4 + jj) * 168 + ci * 16 + c] = f2bf(S[ci][jj]);
  _Pragma("unroll") for (int jj = 0; jj < 4; ++jj) Pl[(q * 4 + jj) * 168 + 144 + c] = 0;
  asm volatile("s_waitcnt lgkmcnt(0)" ::: "memory");
  bf16x8 pf[5];
  _Pragma("unroll") for (int kk = 0; kk < 5; ++kk) pf[kk] = *(const bf16x8*)(Pl + c * 168 + kk * 32 + q * 8);
  asm volatile("s_waitcnt lgkmcnt(0)" ::: "memory");
  float il[4];
  _Pragma("unroll") for (int jj = 0; jj < 4; ++jj) il[jj] = frcp(ls[jj]);
  bfu* Ow = Pl;
  _Pragma("unroll") for (int dt = 0; dt < 8; ++dt) {
    f32x4 a = (f32x4){0.f, 0.f, 0.f, 0.f};
    _Pragma("unroll") for (int kk = 0; kk < 5; ++kk) {
      const int k0_ = w * 16 + kk * 32 + q * 8; const int ch_ = k0_ >> 3;
      const int chp_ = (ch_ < 32) ? (ch_ ^ (((dt * 16 + c) >> 3) & 15)) : ch_;
      bf16x8 vf = *(const bf16x8*)(Vt + (dt * 16 + c) * 280 + chp_ * 8);
      a = __builtin_amdgcn_mfma_f32_16x16x32_bf16(pf[kk], vf, a, 0, 0, 0);
    }
    _Pragma("unroll") for (int jj = 0; jj < 4; ++jj) Ow[(q * 4 + jj) * 136 + dt * 16 + c] = f2bf(a[jj] * il[jj]);
  }
  asm volatile("s_waitcnt lgkmcnt(0)" ::: "memory");
  _Pragma("unroll") for (int i = 0; i < 4; ++i) {
    const int id = lane + 64 * i; const int rr = id >> 4, c8 = id & 15;
    long orow = rowb + (long)(qb * 128 + w * 16 + rr) * dil + r;
    *(bf16x8*)(buf + orow * 4608 + qcol + c8 * 8) = *(const bf16x8*)(Ow + rr * 136 + c8 * 8);
  }
  if (c == 0) {
    _Pragma("unroll") for (int jj = 0; jj < 4; ++jj) {
      long orow = rowb + (long)(qb * 128 + w * 16 + q * 4 + jj) * dil + r;
      misc[MF_LSE + ((long)pat * MTOK + orow) * 4 + head] = mx[jj] + flog(ls[jj]);
    }
  }
}

__device__ void hg_pre_item(const Params& p, int L, int idx) {
  const int li = L >> 1;
  float* misc = (float*)(p.ws + MISC_OFF);
  bfu* buf = (bfu*)(p.ws + R_OFF);
  const int b = idx >> 8, h = (idx >> 6) & 3, n = idx & 63;
  const long R0 = (long)b * TSEQ + n * 64;
  int zoff = 0; asm volatile("" : "+v"(zoff));
  unsigned char* sb = smem + zoff;
  float* bs = (float*)sb;
  bfu* qb = (bfu*)(sb + 33792);
  bfu* kb = (bfu*)(sb + 51200);
  bfu* vT = (bfu*)(sb + 68608);
  bfu* qt = (bfu*)(sb + 87040);
  bfu* kt = (bfu*)(sb + 104448);
  bfu* at = (bfu*)(sb + 130560);
  int tid = ptid_(p.tid); asm volatile("" : "+v"(tid));
  const int wid = tid >> 6, lane = tid & 63, c16 = lane & 15, q4 = lane >> 4;
  const float LOG2E = 1.4426950408889634f;
  __syncthreads();
  for (int e = tid; e < 64 * 72 / 2; e += NTHR) ((unsigned*)at)[e] = 0u;
  { const int d = tid & 127, rg = tid >> 7;
    const float lb = misc[MF_LB + li * 512 + h * 128 + d];
    bfu hqv[16], hfv[16], hiv[16];
    _Pragma("unroll") for (int i = 0; i < 16; ++i) {
      const bfu* pr = buf + (R0 + rg * 16 + i) * 4608 + 1536 + h * 128 + d;
      hqv[i] = pr[0]; hfv[i] = pr[512]; hiv[i] = pr[1024];
    }
    _Pragma("unroll") for (int i = 0; i < 16; ++i) {
      const int r = rg * 16 + i;
      float hq = bf2f(hqv[i]), hf = bf2f(hfv[i]);
      float sg = sigmoidf_(hf);
      float f = lb + (1.0f - lb) * sg;
      qb[r * 136 + d] = f2bf(siluf_(hq));
      kb[r * 136 + d] = f2bf((1.0f - lb) * sigmoidf_(-hf));
      bs[r * 132 + d] = __builtin_amdgcn_logf(f);
      vT[d * 72 + r] = hiv[i];
    }
  }
  __syncthreads();
  if (tid < 128) { float a = 0.f; for (int r = 0; r < 64; ++r) { a += bs[r * 132 + tid]; bs[r * 132 + tid] = a; } }
  __syncthreads();
  { const int d = tid & 127, rg = tid >> 7;
    const float rown = (rg == 0) ? 0.f : bs[(16 * rg - 1) * 132 + d];
    const float r1 = bs[15 * 132 + d], r2 = bs[31 * 132 + d], r3 = bs[47 * 132 + d];
    for (int r = rg * 16; r < rg * 16 + 16; ++r) {
      const float bb = bs[r * 132 + d];
      const float qv = bf2f(qb[r * 136 + d]), kv = bf2f(kb[r * 136 + d]);
      qt[r * 136 + d] = f2bf(qv * __builtin_amdgcn_exp2f(bb - rown));
      { const int Lq = fragA_128(r, d); buf[(R0 + (Lq >> 7)) * 4608 + 1536 + h * 128 + (Lq & 127)] = f2bf(qv * __builtin_amdgcn_exp2f(bb)); }
      if (rg < 1) kt[(0 + r) * 136 + d] = f2bf(kv * __builtin_amdgcn_exp2f(r1 - bb));
      if (rg < 2) kt[(16 + r) * 136 + d] = f2bf(kv * __builtin_amdgcn_exp2f(r2 - bb));
      if (rg < 3) kt[(48 + r) * 136 + d] = f2bf(kv * __builtin_amdgcn_exp2f(r3 - bb));
    }
    if (tid < 128) misc[MF_EB + (long)idx * 128 + tid] = __builtin_amdgcn_exp2f(bs[63 * 132 + tid]);
  }
  { const int s = tid & 63, dg = tid >> 6;
    for (int d = dg * 16; d < dg * 16 + 16; ++d) {
      float kd = bf2f(kb[s * 136 + d]) * __builtin_amdgcn_exp2f(bs[63 * 132 + d] - bs[s * 132 + d]);
      { const int Lk = fragA_64(d, s); buf[(R0 + (Lk >> 7)) * 4608 + 2048 + h * 128 + (Lk & 127)] = f2bf(kd); }
    }
  }
  for (int ch = tid; ch < 1024; ch += NTHR) {
    const int e = ch >> 3, c8 = ch & 7;
    { const int Lv = fragA_64(e, c8 * 8); *(u32x4*)(buf + (R0 + (Lv >> 7)) * 4608 + 2560 + h * 128 + (Lv & 127)) = *(const u32x4*)(vT + e * 72 + c8 * 8); }
  }
  for (int rd = 0; rd < 9; ++rd) {
    const int pi = (rd * NTHR + tid) >> 3, part = tid & 7;
    const bool act = pi < 544;
    const int pj = act ? pi : 0;
    const int blk = pj / 136, tri = pj - blk * 136;
    int t = (int)((__builtin_amdgcn_sqrtf((float)(8 * tri + 1)) - 1.0f) * 0.5f);
    if ((t + 1) * (t + 2) / 2 <= tri) ++t;
    if (t * (t + 1) / 2 > tri) --t;
    const int s = tri - t * (t + 1) / 2;
    const int T = blk * 16 + t, S = blk * 16 + s;
    float acc = 0.f;
    _Pragma("unroll") for (int e = 0; e < 16; ++e) {
      const int d = part * 16 + e;
      acc += bf2f(qb[T * 136 + d]) * bf2f(kb[S * 136 + d]) * __builtin_amdgcn_exp2f(bs[T * 132 + d] - bs[S * 132 + d]);
    }
    acc += SHX(acc, 1); acc += SHX(acc, 2); acc += SHX(acc, 4);
    if (part == 0 && act) at[T * 72 + S] = f2bf(acc);
  }
  __syncthreads();
  if (wid < 6) {
    const int i = (wid < 1) ? 1 : (wid < 3 ? 2 : 3);
    const int j = (wid < 1) ? 0 : (wid < 3 ? (wid - 1) : (wid - 3));
    const int kbase = (i == 1) ? 0 : (i == 2 ? 16 : 48);
    f32x4 a = (f32x4){0.f, 0.f, 0.f, 0.f};
    _Pragma("unroll") for (int kk = 0; kk < 4; ++kk) {
      bf16x8 af = *(const bf16x8*)(qt + (i * 16 + c16) * 136 + kk * 32 + q4 * 8);
      bf16x8 bf = *(const bf16x8*)(kt + (kbase + j * 16 + c16) * 136 + kk * 32 + q4 * 8);
      a = __builtin_amdgcn_mfma_f32_16x16x32_bf16(af, bf, a, 0, 0, 0);
    }
    _Pragma("unroll") for (int jj = 0; jj < 4; ++jj) at[(i * 16 + q4 * 4 + jj) * 72 + j * 16 + c16] = f2bf(a[jj]);
  }
  __syncthreads();
  { bf16x8 bv[2];
    _Pragma("unroll") for (int k2 = 0; k2 < 2; ++k2) bv[k2] = *(const bf16x8*)(vT + (wid * 16 + c16) * 72 + k2 * 32 + q4 * 8);
    _Pragma("unroll") for (int rt = 0; rt < 4; ++rt) {
      f32x4 a = (f32x4){0.f, 0.f, 0.f, 0.f};
      _Pragma("unroll") for (int k2 = 0; k2 < 2; ++k2) {
        bf16x8 af = *(const bf16x8*)(at + (rt * 16 + c16) * 72 + k2 * 32 + q4 * 8);
        a = __builtin_amdgcn_mfma_f32_16x16x32_bf16(af, bv[k2], a, 0, 0, 0);
      }
      _Pragma("unroll") for (int jj = 0; jj < 4; ++jj)
        buf[(R0 + rt * 16 + q4 * 4 + jj) * 4608 + 3584 + h * 128 + wid * 16 + c16] = f2bf(a[jj]);
    }
  }
}

__device__ void hg_scan_block(const Params& p, int L, int item) {
  float* misc = (float*)(p.ws + MISC_OFF);
  bfu* buf = (bfu*)(p.ws + R_OFF);
  const int bh = item >> 2, qt = item & 3;
  int tid = ptid_(p.tid); asm volatile("" : "+v"(tid));
  const int w = tid >> 6, lane = tid & 63, c = lane & 15, q = lane >> 4;
  const int rt = w >> 1, ct = w & 1, dt = w;
  bfu* St = (bfu*)smem;
  const int b = bh >> 2, h = bh & 3;
  __syncthreads();
  for (int i = tid; i < 4 * 2176; i += NTHR) St[i] = 0;
  f32x4 Sacc[2];
  Sacc[0] = (f32x4){0.f, 0.f, 0.f, 0.f}; Sacc[1] = Sacc[0];
#define HG_DECL(X) bf16x8 qd##X[4], kd##X[2], vt##X[2][2]; float oi##X[4], eb##X[4];
  HG_DECL(A) HG_DECL(B) HG_DECL(C)
#define HG_LOAD(X, nn) do { const long R0 = (long)b * TSEQ + (nn) * 64; \
    const bfu* hb_ = buf + (R0 + (lane >> 4)) * 4608 + h * 128 + (lane & 15) * 8; \
    _Pragma("unroll") for (int kk = 0; kk < 4; ++kk) qd##X[kk] = *(const bf16x8*)(hb_ + (long)((rt * 4 + kk) * 4) * 4608 + 1536); \
    _Pragma("unroll") for (int k2 = 0; k2 < 2; ++k2) { \
      kd##X[k2] = *(const bf16x8*)(hb_ + (long)((dt * 2 + k2) * 4) * 4608 + 2048); \
      _Pragma("unroll") for (int cc = 0; cc < 2; ++cc) \
        vt##X[cc][k2] = *(const bf16x8*)(hb_ + (long)(((qt * 2 + cc) * 2 + k2) * 4) * 4608 + 2560); } \
    _Pragma("unroll") for (int j = 0; j < 4; ++j) { oi##X[j] = bf2f(buf[(R0 + rt * 16 + q * 4 + j) * 4608 + 3584 + h * 128 + qt * 32 + ct * 16 + c]); \
      eb##X[j] = misc[MF_EB + ((long)bh * 64 + (nn)) * 128 + dt * 16 + q * 4 + j]; } } while (0)
#define HG_STEP(X, n) do { \
    const bfu* Sc = St + ((n) & 1) * 4352; \
    bfu* Sn = St + (((n) + 1) & 1) * 4352; \
    f32x4 o; \
    _Pragma("unroll") for (int j = 0; j < 4; ++j) o[j] = oi##X[j]; \
    _Pragma("unroll") for (int kk = 0; kk < 4; ++kk) { \
      bf16x8 bS = *(const bf16x8*)(Sc + ct * 2176 + c * 136 + kk * 32 + q * 8); \
      o = __builtin_amdgcn_mfma_f32_16x16x32_bf16(qd##X[kk], bS, o, 0, 0, 0); } \
    _Pragma("unroll") for (int j = 0; j < 4; ++j) { \
      long row = (long)b * TSEQ + (n) * 64 + rt * 16 + q * 4 + j; \
      buf[row * 4608 + 3584 + h * 128 + qt * 32 + ct * 16 + c] = f2bf(o[j]); } \
    _Pragma("unroll") for (int cc = 0; cc < 2; ++cc) { \
      f32x4 a; \
      _Pragma("unroll") for (int j = 0; j < 4; ++j) a[j] = Sacc[cc][j] * eb##X[j]; \
      _Pragma("unroll") for (int k2 = 0; k2 < 2; ++k2) a = __builtin_amdgcn_mfma_f32_16x16x32_bf16(kd##X[k2], vt##X[cc][k2], a, 0, 0, 0); \
      Sacc[cc] = a; \
      uint2 so; so.x = pack2(a[0], a[1]); so.y = pack2(a[2], a[3]); \
      *(uint2*)(Sn + cc * 2176 + c * 136 + dt * 16 + q * 4) = so; } \
    LBAR; } while (0)
  HG_LOAD(A, 0); HG_LOAD(B, 1);
  __syncthreads();
  for (int n = 0; n < 63; n += 3) {
    HG_LOAD(C, n + 2); HG_STEP(A, n);
    HG_LOAD(A, n + 3); HG_STEP(B, n + 1);
    if (n + 4 < 64) HG_LOAD(B, n + 4);
    HG_STEP(C, n + 2);
  }
  HG_STEP(A, 63);
}

__device__ void cd_fin_rows(const Params& p, int L, int row0, int nrows, const bool doC, const bool doD) {
  const int li = L >> 1;
  const float* misc = (const float*)(p.ws + MISC_OFF);
  bfu* buf = (bfu*)(p.ws + R_OFF);
  int tid = ptid_(p.tid); asm volatile("" : "+v"(tid)); const int wid = tid >> 6, lane = tid & 63;
  for (int rr = wid; rr < nrows; rr += 8) {
    const long row = row0 + rr;
    bfu* pr = buf + row * 4608;
    const int c0 = lane * 8;
    if (doC) {
    bf16x8 o = *(const bf16x8*)(pr + 3584 + c0);
    bf16x8 hg = *(const bf16x8*)(pr + 1536 + 1536 + c0);
    float of[8]; float ss = 0.f;
    for (int e = 0; e < 8; ++e) { of[e] = bf2f((bfu)o[e]); ss += of[e] * of[e]; }
    ss += SHX(ss, 1); ss += SHX(ss, 2); ss += SHX(ss, 4); ss += SHX(ss, 8);
    const float rs = frsq(ss * (1.0f / 128.0f) + 1e-6f);
    float ra[8];
    for (int e = 0; e < 8; ++e) ra[e] = of[e] * rs * p.hg_norm_g[li * 128 + ((c0 + e) & 127)] * sigmoidf_(bf2f((bfu)hg[e]));
    uint4 wa; wa.x = pack2(ra[0], ra[1]); wa.y = pack2(ra[2], ra[3]); wa.z = pack2(ra[4], ra[5]); wa.w = pack2(ra[6], ra[7]);
    *(uint4*)(pr + 1536 + c0) = wa;
    }
    if (doD) {
    const int head = lane >> 4;
    float l0 = misc[MF_LSE + ((long)0 * MTOK + row) * 4 + head];
    float l1 = misc[MF_LSE + ((long)1 * MTOK + row) * 4 + head];
    float l2 = misc[MF_LSE + ((long)2 * MTOK + row) * 4 + head];
    float mm = fmaxf(l0, fmaxf(l1, l2));
    float e0 = fexp(l0 - mm), e1 = fexp(l1 - mm), e2 = fexp(l2 - mm);
    float inv = frcp(e0 + e1 + e2);
    e0 *= inv; e1 *= inv; e2 *= inv;
    bf16x8 o0 = *(const bf16x8*)(pr + c0), o1 = *(const bf16x8*)(pr + 512 + c0), o2 = *(const bf16x8*)(pr + 1024 + c0);
    float rd[8];
    for (int e = 0; e < 8; ++e) rd[e] = e0 * bf2f((bfu)o0[e]) + e1 * bf2f((bfu)o1[e]) + e2 * bf2f((bfu)o2[e]);
    uint4 wb; wb.x = pack2(rd[0], rd[1]); wb.y = pack2(rd[2], rd[3]); wb.z = pack2(rd[4], rd[5]); wb.w = pack2(rd[6], rd[7]);
    *(uint4*)(pr + c0) = wb;
    }
  }
}


#define XB_TMO      128
#define XB_XCNT(j)  (256  + 64 * (j))
#define XB_XSUB(j)  (1280 + 64 * (j))
#define XB_XGEN(j)  (2304 + 64 * (j))
#define XB_TOP      3328
#define XB_TOPGEN   3392
#define XCD_BAR_WORDS 3456
#define XB_SPIN_CAP (1u << 18)
#define LAS __attribute__((address_space(3)))
__device__ __forceinline__ unsigned xb_ld(unsigned* p)              { return __hip_atomic_load(p, __ATOMIC_RELAXED, __HIP_MEMORY_SCOPE_AGENT); }
__device__ __forceinline__ unsigned xb_add(unsigned* p, unsigned v) { return __hip_atomic_fetch_add(p, v, __ATOMIC_RELAXED, __HIP_MEMORY_SCOPE_AGENT); }
__device__ __forceinline__ unsigned xb_xcc_id() { return (unsigned)__builtin_amdgcn_s_getreg((3 << 11) | 20) & 0xFu; }
#define XB_SPIN(cond, bar) do { unsigned _sp = 0; while (cond) { __builtin_amdgcn_s_sleep(1); \
    if ((++_sp & 255u) == 0u) { if (xb_ld(&(bar)[XB_TMO])) break; if (_sp > XB_SPIN_CAP) { atomicAdd(&(bar)[XB_TMO], 1u); break; } } } } while (0)
struct XcdBarrier { unsigned* bar; unsigned x; volatile LAS unsigned* st; };
__device__ __forceinline__ XcdBarrier xcd_barrier_post(unsigned* bar, volatile LAS unsigned* st) {
  XcdBarrier b; b.bar = bar; b.x = xb_xcc_id(); b.st = st;
  if (threadIdx.x == 0) (void)xb_add(&bar[XB_XCNT(b.x)], 1u);
  return b;
}
__device__ __forceinline__ void xcd_barrier_complete(unsigned* bar, unsigned x, unsigned& nloc, unsigned& nx) {
  const unsigned G = gridDim.x * gridDim.y * gridDim.z;
  unsigned sum, cnt, mine, sp = 0u;
  for (;;) {
    sum = 0u; cnt = 0u; mine = 0u;
#pragma unroll
    for (unsigned j = 0; j < 16; ++j) { const unsigned c = xb_ld(&bar[XB_XCNT(j)]); sum += c; cnt += (c > 0u) ? 1u : 0u; mine = (j == x) ? c : mine; }
    if (sum == G) break;
    __builtin_amdgcn_s_sleep(1);
    if ((++sp & 255u) == 0u) { if (xb_ld(&bar[XB_TMO])) break; if (sp > XB_SPIN_CAP) { atomicAdd(&bar[XB_TMO], 1u); break; } }
  }
  nloc = mine > 0u ? mine : 1u; nx = cnt > 0u ? cnt : 1u;
}
__device__ __forceinline__ void xcd_barrier(const XcdBarrier& b) {
  asm volatile("s_waitcnt vmcnt(0)" ::: "memory");
  __syncthreads();
  if (threadIdx.x == 0) {
    unsigned* bar = b.bar;
    __builtin_amdgcn_s_waitcnt(0);
    unsigned nloc = b.st[0], nx = b.st[1];
    if (nloc == 0u) { xcd_barrier_complete(bar, b.x, nloc, nx); b.st[0] = nloc; b.st[1] = nx; }
    const unsigned old = xb_add(&bar[XB_XSUB(b.x)], 1u);
    const unsigned gen = old / nloc;
    if (old + 1u == (gen + 1u) * nloc) {
      __builtin_amdgcn_fence(__ATOMIC_RELEASE, "agent");
      asm volatile("s_waitcnt vmcnt(0)" ::: "memory");
      const unsigned og = xb_add(&bar[XB_TOP], 1u);
      const unsigned tg = og / nx;
      if (og + 1u == (tg + 1u) * nx) xb_add(&bar[XB_TOPGEN], 1u);
      else XB_SPIN(xb_ld(&bar[XB_TOPGEN]) == tg, bar);
      __builtin_amdgcn_fence(__ATOMIC_ACQUIRE, "agent");
      xb_add(&bar[XB_XGEN(b.x)], 1u);
      asm volatile("s_waitcnt vmcnt(0)" ::: "memory");
    } else {
      XB_SPIN(xb_ld(&bar[XB_XGEN(b.x)]) == gen, bar);
      __builtin_amdgcn_fence(__ATOMIC_ACQUIRE, "agent");
      asm volatile("s_waitcnt vmcnt(0)" ::: "memory");
    }
  }
  __syncthreads();
}

__global__ void __launch_bounds__(NTHR, 2) fwd_megakernel(Params p) {
  cg::grid_group grid = cg::this_grid();
  const int G = gridDim.x;
  const int wave_id_ = __builtin_amdgcn_readfirstlane((int)(threadIdx.x >> 6));
  volatile LAS unsigned* xb_st = (volatile LAS unsigned*)(smem + 163824);
  if (threadIdx.x == 0) { xb_st[0] = 0u; xb_st[1] = 0u; xb_st[2] = 0u; xb_st[3] = 0u; }
  __syncthreads();
  XcdBarrier xb = xcd_barrier_post((unsigned*)(p.ws + BAR_BYTE_OFF), xb_st);
  for (int ph = p.phase_lo; ph < p.phase_hi; ++ph) {
    int L = 0, kind = 0;
    if (ph == 0) kind = 0;
    else if (ph >= 33) kind = 14;
    else {
      int r = ph - 1;
      if (r < 7) { L = 0; } else if (r < 16) { L = 1; r -= 7; } else if (r < 23) { L = 2; r -= 16; } else { L = 3; r -= 23; }
      if ((L & 1) == 0) kind = 1 + r;
      else kind = (r < 6) ? (8 + r) : (5 + (r - 6));
    }
    const long wb = wt_base(L);
    const bool even = (L & 1) == 0;
    const long w_out = wb + (even ? 3584L : 6656L) * 1024, w_gu = wb + (even ? 4608L : 7680L) * 1024, w_dn = wb + (even ? 10240L : 13312L) * 1024;
#ifndef REPEAT_MASK
#define REPEAT_MASK 0
#endif
#ifndef REPEAT_N
#define REPEAT_N 1
#endif
    const int nrep = ((REPEAT_MASK >> kind) & 1) ? REPEAT_N : 1;
    for (int rep = 0; rep < nrep; ++rep) {
    if (rep > 0) xcd_barrier(xb);
    { p.tid = wave_id_;
      int b_ = blockIdx.x; asm volatile("" : "+s"(b_)); p.bid = b_;
      }
    float* misc = (float*)(p.ws + MISC_OFF);
    const bfu* wt = (const bfu*)(p.ws + WT_OFF);
    bfu* hb = (bfu*)(p.ws + HB_OFF);
    float* rs_mix = misc + MF_RSP + (L == 0 ? 0L : 2L * MTOK * 16);
    float* rs_ffn = misc + MF_RSP + 1L * MTOK * 16;
    float* rs_next = misc + MF_RSP + 2L * MTOK * 16;
    bfu* pab = (bfu*)(p.ws + PAB_OFF);
    bfu* buf = (bfu*)(p.ws + R_OFF);
    switch (kind) {
      case 0: phase_prologue(p); break;
      case 1: case 10: {
        GemmArgs g{}; g.tid = p.tid; g.A = hb; g.lda = 1024; g.asplit = 1 << 30; g.K = 1024; g.rowss = rs_mix;
        if (kind == 1) { g.Bt = wt + wb; g.outb = pab; g.ldo = 3584; g.ocol0 = 0; gemm_phase<EPI_PLAIN>(g, 128, 14, 256, p, L); }
        else { g.Bt = wt + wb + 4608L * 1024; g.outb = buf; g.ldo = 4608; g.ocol0 = 1536; gemm_phase<EPI_PLAIN>(g, 128, 8, 0, p, L); }
      } break;
      case 2: for (int it = p.bid; it < 2048; it += G) dn_pre_item(p, L, it); break;
      case 3: case 12: {
        const bool big = G >= 256;
        const int VG = big ? G - 128 : G, vb = big ? p.bid - 128 : p.bid;
        if (!big || p.bid < 128) {
          for (int it = p.bid; it < 128; it += (big ? 128 : G)) {
            const int item = (it & 7) * 16 + (it >> 3);
            if (kind == 3) dn_scan_block(p, L, item); else hg_scan_block(p, L, item);
          }
        }
        if ((!big || p.bid >= 128) && rep == 0) {
          const int cL0 = L, cj0 = (L & 1) ? 2 : 1, cL1 = (L < 3) ? L + 1 : 3, cj1 = (L == 3) ? 4 : ((L & 1) ? 0 : 1);
          cvt_jobs(p, cL0, cj0, cL1, cj1, vb, VG);
        }
        if ((!big || p.bid >= 128) && rep == nrep - 1) {
          for (int it = vb; it < 256; it += VG) {
            if (kind == 3) ab_fin_rows(p, L, it * 128, 128, false, true); else cd_fin_rows(p, L, it * 128, 128, false, true);
          }
        }
      } break;
      case 4: for (int it = p.bid; it < 256; it += G) ab_fin_rows(p, L, it * 128, 128, true, false); break;
      case 5: case 7: {
        GemmArgs g{}; g.tid = p.tid; g.asplit = 1 << 30; g.hout = p.out; g.hb = hb; g.hres = p.x; g.res_bf16 = (kind == 5 && L == 0) ? 0 : 1;
        if (kind == 5) {
          g.K = 1024; g.Bt = wt + w_out; g.rowss_next = rs_ffn;
          if (even) { g.A = pab; g.lda = 3584; g.aoff0 = 512; }
          else { g.A = buf; g.lda = 4608; g.aoff0 = 1536; g.aoff1 = 0; g.asplit = 512; }
        } else { g.A = buf; g.lda = 2816; g.K = 2816; g.Bt = wt + w_dn; g.rowss_next = rs_next; }
        gemm_phase<EPI_RES>(g, 128, 4, 0, p, L);
      } break;
      case 6: {
        GemmArgs g{}; g.tid = p.tid; g.A = hb; g.lda = 1024; g.asplit = 1 << 30; g.Bt = wt + w_gu; g.K = 1024;
        g.rowss = rs_ffn; g.outb = buf; g.ldo = 2816; g.ocol0 = 0;
        gemm_phase<EPI_GLU>(g, 128, 22, 0, p, L);
      } break;
      case 8: {
        GemmArgs g{}; g.tid = p.tid; g.A = hb; g.lda = 1024; g.asplit = 1 << 30; g.Bt = wt + wb; g.K = 1024;
        g.rowss = rs_mix; g.outb = buf; g.ldo = 4608; g.ocol0 = 0; g.rope = misc + MF_ROPE;
        gemm_phase<EPI_SWA>(g, 128, 18, 0, p, L);
      } break;
      case 9: for (int it = remap_block(p.bid, G); it < 3072; it += G) swa_item(p, it); break;
      case 11: for (int it = p.bid; it < 2048; it += G) hg_pre_item(p, L, it); break;
      case 13: for (int it = p.bid; it < 256; it += G) cd_fin_rows(p, L, it * 128, 128, true, false); break;
      default: {
        const float* rsf = misc + MF_RSP + 2L * MTOK * 16;
        const int tid_f = ptid_(p.tid); const int wid = tid_f >> 6, lane = tid_f & 63;
        const int c = lane * 16;
        f32x4 gg[4];
        _Pragma("unroll") for (int i = 0; i < 4; ++i) gg[i] = *(const f32x4*)(p.norm_final_g + c + i * 4);
        for (int r0 = (p.bid * 8 + wid) * 4; r0 < MTOK; r0 += G * 32) {
          f32x4 ps[4][4]; bf16x8 hv[4][2];
          _Pragma("unroll") for (int u = 0; u < 4; ++u) {
            _Pragma("unroll") for (int i = 0; i < 4; ++i) ps[u][i] = *(const f32x4*)(rsf + (long)(r0 + u) * 16 + i * 4);
            hv[u][0] = *(const bf16x8*)(hb + (long)(r0 + u) * 1024 + c); hv[u][1] = *(const bf16x8*)(hb + (long)(r0 + u) * 1024 + c + 8);
          }
          _Pragma("unroll") for (int u = 0; u < 4; ++u) {
            float s16 = 0.f;
            _Pragma("unroll") for (int i = 0; i < 4; ++i) s16 += (ps[u][i][0] + ps[u][i][1]) + (ps[u][i][2] + ps[u][i][3]);
            const float rs = frsq(s16 * (1.0f / 1024.0f) + 1e-6f);
            float* pr = p.out + (long)(r0 + u) * 1024 + c;
            _Pragma("unroll") for (int i = 0; i < 4; ++i) {
              f32x4 o;
              _Pragma("unroll") for (int e = 0; e < 4; ++e) o[e] = bf2f((bfu)hv[u][i >> 1][(i & 1) * 4 + e]) * rs * gg[i][e];
              *(f32x4*)(pr + i * 4) = o;
            }
          }
        }
      } break;
    }
    }
    if (ph + 1 < p.phase_hi) { if (ph == p.phase_lo) grid.sync(); else xcd_barrier(xb); }
  }
}

extern "C" void kernel_launch(void* const* d_in, const int* in_sizes, int n_in, void* d_out, int out_size,
                              void* d_ws, size_t ws_size, hipStream_t stream) {
  constexpr size_t kDynLds = 160 * 1024;
  static int grid_blocks = 0;
  if (!grid_blocks) {
    int dev = 0, cus = 0, per_cu = 0;
    (void)hipGetDevice(&dev);
    (void)hipDeviceGetAttribute(&cus, hipDeviceAttributeMultiprocessorCount, dev);
    (void)hipFuncSetAttribute((const void*)fwd_megakernel, hipFuncAttributeMaxDynamicSharedMemorySize, (int)kDynLds);
    (void)hipOccupancyMaxActiveBlocksPerMultiprocessor(&per_cu, fwd_megakernel, NTHR, kDynLds);
    if (per_cu < 1) per_cu = 1;
    grid_blocks = cus * per_cu;
  }
  Params p{};
  const float** f = (const float**)&p;
  for (int i = 0; i < 18; ++i) f[i] = (const float*)d_in[i];
  p.out = (float*)d_out; p.ws = (char*)d_ws;
  p.phase_lo = 0; p.phase_hi = 34;
  (void)hipMemsetAsync((char*)d_ws + BAR_BYTE_OFF, 0, XCD_BAR_WORDS * sizeof(unsigned), stream);
  void* args[] = {&p};
  hipError_t e = hipLaunchCooperativeKernel((void*)fwd_megakernel, dim3(grid_blocks), dim3(NTHR), args, kDynLds, stream);
  if (e != hipSuccess) fprintf(stderr, "cooperative launch failed: %s (grid %d)\n", hipGetErrorString(e), grid_blocks);
}
```
